# Optimizing an MI355X kernel written in HIP

```python
import math, functools
import jax, jax.numpy as jnp
from jax import lax
import numpy as np

D_MODEL = 2048
BATCH = 4
SEQ = 4096
DEPTH = 1

RET_HEADS = 8
RET_DK = 128
RET_DV = 256
RET_CHUNK = 128
ROPE_BASE = 10000.0
NSA_HEADS = 16
NSA_GROUPS = 2
NSA_HPG = NSA_HEADS // NSA_GROUPS
NSA_DH = 128
CMP_BLOCK = 32
CMP_STRIDE = 16
CMP_HIDDEN = 256
SLC_BLOCK = 64
SLC_TOPK = 16
WINDOW = 512
Q_BLOCK = 128
FORCE_SCORE = 1e4
D_FF = 5632
CONV_W = 3
EPS = 1e-6

RET_QW = RET_HEADS * RET_DK
RET_VW = RET_HEADS * RET_DV
NSA_QW = NSA_HEADS * NSA_DH
NSA_KVW = NSA_GROUPS * NSA_DH
SPLIT_SIZES = [RET_QW, RET_QW, RET_VW, RET_VW,
               NSA_QW, 6 * NSA_KVW, 3 * NSA_HEADS,
               2 * D_MODEL]
SPLIT_OFFSETS = [int(o) for o in np.cumsum(SPLIT_SIZES)[:-1]]
IN_COLS = int(sum(SPLIT_SIZES))

kernel_name = "hybrid_retention_nsa_convffn"


def rmsnorm(x, w):
    xf = x.astype(jnp.float32)
    y = xf * lax.rsqrt(jnp.mean(xf * xf, axis=-1, keepdims=True) + EPS)
    return (y * w).astype(x.dtype)


def head_rmsnorm(x):
    xf = x.astype(jnp.float32)
    return (xf * lax.rsqrt(jnp.mean(xf * xf, axis=-1, keepdims=True) + EPS)).astype(x.dtype)


def masked_softmax(s, mask):
    s = jnp.where(mask, s.astype(jnp.float32), -jnp.inf)
    m = jnp.max(s, axis=-1, keepdims=True)
    m = jnp.where(jnp.isfinite(m), m, 0.0)
    p = jnp.exp(s - m)
    return p / jnp.maximum(jnp.sum(p, axis=-1, keepdims=True), 1e-30)


def rotary(x, pos):
    d = x.shape[-1]
    half = d // 2
    freq = ROPE_BASE ** (-jnp.arange(half, dtype=jnp.float32) / half)
    ang = pos.astype(jnp.float32)[:, None] * freq[None, :]
    cos, sin = jnp.cos(ang), jnp.sin(ang)
    x1, x2 = x[..., :half], x[..., half:]
    return jnp.concatenate([x1 * cos - x2 * sin, x1 * sin + x2 * cos], axis=-1).astype(x.dtype)


def retention_chunkwise(q, k, v):
    B, H, S, dk = q.shape
    dv = v.shape[-1]
    C = RET_CHUNK
    nC = S // C
    log_gamma = jnp.log(1.0 - 2.0 ** (-5.0 - jnp.arange(H, dtype=jnp.float32)))
    q = q.reshape(B, H, nC, C, dk)
    k = k.reshape(B, H, nC, C, dk)
    v = v.reshape(B, H, nC, C, dv)
    j = jnp.arange(C, dtype=jnp.float32)
    rel = j[:, None] - j[None, :]
    decay = jnp.where(rel >= 0, jnp.exp(log_gamma[:, None, None] * jnp.maximum(rel, 0.0)), 0.0)
    scores = jnp.einsum('bhcnd,bhcmd->bhcnm', q, k) * decay[None, :, None]
    inner = jnp.einsum('bhcnm,bhcme->bhcne', scores, v)
    k_decay = jnp.exp(log_gamma[:, None] * (C - 1 - j)[None, :])
    kv = jnp.einsum('bhcjd,hj,bhcje->bhcde', k, k_decay, v)
    chunk_decay = jnp.exp(log_gamma * C)[None, :, None, None]

    def step(state, kv_c):
        return state * chunk_decay + kv_c, state

    _, states = lax.scan(step, jnp.zeros((B, H, dk, dv), kv.dtype), jnp.moveaxis(kv, 2, 0))
    states = jnp.moveaxis(states, 0, 2)
    q_decay = jnp.exp(log_gamma[:, None] * (j + 1.0)[None, :])
    cross = jnp.einsum('bhcnd,bhcde->bhcne', q, states) * q_decay[None, :, None, :, None]
    return (inner + cross).reshape(B, H, S, dv)


def compress_blocks(x, tok, pe, w1, w2):
    blocks = x[:, :, tok] + pe
    flat = blocks.reshape(blocks.shape[0], blocks.shape[1], blocks.shape[2], CMP_BLOCK * x.shape[-1])
    return jax.nn.gelu(flat @ w1) @ w2


def native_sparse_attention(q, k_c, v_c, k_s, v_s, k_w, v_w, gates,
                            pe_k, w1_k, w2_k, pe_v, w1_v, w2_v):
    B, G, S, Dh = k_s.shape
    R = NSA_HPG
    n_cmp = (S - CMP_BLOCK) // CMP_STRIDE + 1
    n_slc = S // SLC_BLOCK
    top_n = min(SLC_TOPK, n_slc)
    cmp_start = np.arange(n_cmp) * CMP_STRIDE
    tok = cmp_start[:, None] + np.arange(CMP_BLOCK)[None, :]
    k_cmp = compress_blocks(k_c, tok, pe_k, w1_k, w2_k)
    v_cmp = compress_blocks(v_c, tok, pe_v, w1_v, w2_v)
    cmp_end = jnp.asarray(cmp_start + CMP_BLOCK - 1, jnp.int32)
    slc_start = np.arange(n_slc) * SLC_BLOCK
    overlap = jnp.asarray(((cmp_start[:, None] < slc_start[None, :] + SLC_BLOCK) &
                           (cmp_start[:, None] + CMP_BLOCK > slc_start[None, :])).astype(np.float32))
    k_blocks = k_s.reshape(B, G, n_slc, SLC_BLOCK, Dh)
    v_blocks = v_s.reshape(B, G, n_slc, SLC_BLOCK, Dh)
    pad = ((0, 0), (0, 0), (WINDOW, 0), (0, 0))
    k_wp = jnp.pad(k_w, pad)
    v_wp = jnp.pad(v_w, pad)
    qg = q.reshape(B, G, R, S, Dh)
    gg = gates.reshape(B, G, R, S, 3)
    scale = Dh ** -0.5
    blk_ids = jnp.arange(n_slc, dtype=jnp.int32)
    gather = jax.vmap(jax.vmap(lambda kb, ix: kb[ix]))

    def block(start):
        qb = lax.dynamic_slice_in_dim(qg, start, Q_BLOCK, axis=3) * scale
        t = start + jnp.arange(Q_BLOCK, dtype=jnp.int32)
        s_c = jnp.einsum('bgrqd,bgnd->bgrqn', qb, k_cmp)
        p_c = masked_softmax(s_c, cmp_end[None, :] <= t[:, None])
        o_c = jnp.einsum('bgrqn,bgnd->bgrqd', p_c.astype(v_cmp.dtype), v_cmp)
        imp = jnp.einsum('bgrqn,ns->bgqs', p_c, overlap)
        cur = t // SLC_BLOCK
        forced = (blk_ids[None, :] == 0) | (blk_ids[None, :] == cur[:, None]) | (blk_ids[None, :] == cur[:, None] - 1)
        imp = jnp.where(forced, FORCE_SCORE, imp)
        imp = jnp.where(blk_ids[None, :] > cur[:, None], -FORCE_SCORE, imp)
        _, idx = lax.top_k(imp, top_n)
        kg = gather(k_blocks, idx).reshape(B, G, Q_BLOCK, top_n * SLC_BLOCK, Dh)
        vg = gather(v_blocks, idx).reshape(B, G, Q_BLOCK, top_n * SLC_BLOCK, Dh)
        kpos_s = (idx[..., None] * SLC_BLOCK + jnp.arange(SLC_BLOCK, dtype=jnp.int32)).reshape(B, G, Q_BLOCK, top_n * SLC_BLOCK)
        s_s = jnp.einsum('bgrqd,bgqkd->bgrqk', qb, kg)
        p_s = masked_softmax(s_s, (kpos_s <= t[:, None])[:, :, None])
        o_s = jnp.einsum('bgrqk,bgqkd->bgrqd', p_s.astype(vg.dtype), vg)
        kw = lax.dynamic_slice_in_dim(k_wp, start, WINDOW + Q_BLOCK, axis=2)
        vw = lax.dynamic_slice_in_dim(v_wp, start, WINDOW + Q_BLOCK, axis=2)
        kpos_w = start - WINDOW + jnp.arange(WINDOW + Q_BLOCK, dtype=jnp.int32)
        mask_w = (kpos_w[None, :] <= t[:, None]) & (kpos_w[None, :] > t[:, None] - WINDOW) & (kpos_w[None, :] >= 0)
        s_w = jnp.einsum('bgrqd,bgkd->bgrqk', qb, kw)
        p_w = masked_softmax(s_w, mask_w)
        o_w = jnp.einsum('bgrqk,bgkd->bgrqd', p_w.astype(vw.dtype), vw)
        gb = lax.dynamic_slice_in_dim(gg, start, Q_BLOCK, axis=3)
        return gb[..., 0:1] * o_c + gb[..., 1:2] * o_s + gb[..., 2:3] * o_w

    starts = jnp.arange(S // Q_BLOCK, dtype=jnp.int32) * Q_BLOCK
    out = lax.map(block, starts)
    return out.transpose(1, 0, 4, 2, 3, 5).reshape(B, S, NSA_HEADS * Dh)


def causal_dwconv(u, w, b):
    S = u.shape[1]
    up = jnp.pad(u, ((0, 0), (CONV_W - 1, 0), (0, 0)))
    y = up[:, 0:S] * w[0]
    for tap in range(1, CONV_W):
        y = y + up[:, tap:tap + S] * w[tap]
    return y + b


def setup_inputs(seed: int = 0) -> dict:
    key = jax.random.key(seed)
    ks = jax.random.split(key, 20)
    f32 = jnp.float32

    def nrm(k, shape, fan_in):
        return jax.random.normal(k, shape, f32) * (fan_in ** -0.5)

    L = DEPTH
    return {
        "x": jax.random.normal(ks[0], (BATCH, SEQ, D_MODEL), f32),
        "norm1_w": 1.0 + 0.01 * jax.random.normal(ks[1], (L, D_MODEL), f32),
        "w_in": nrm(ks[2], (L, D_MODEL, IN_COLS), D_MODEL),
        "ret_norm_w": 1.0 + 0.01 * jax.random.normal(ks[3], (L, RET_VW), f32),
        "w_ret_up": nrm(ks[4], (L, RET_VW, D_MODEL), RET_VW),
        "cmp_pe_k": 0.02 * jax.random.normal(ks[5], (L, CMP_BLOCK, NSA_DH), f32),
        "cmp_w1_k": nrm(ks[6], (L, CMP_BLOCK * NSA_DH, CMP_HIDDEN), CMP_BLOCK * NSA_DH),
        "cmp_w2_k": nrm(ks[7], (L, CMP_HIDDEN, NSA_DH), CMP_HIDDEN),
        "cmp_pe_v": 0.02 * jax.random.normal(ks[8], (L, CMP_BLOCK, NSA_DH), f32),
        "cmp_w1_v": nrm(ks[9], (L, CMP_BLOCK * NSA_DH, CMP_HIDDEN), CMP_BLOCK * NSA_DH),
        "cmp_w2_v": nrm(ks[10], (L, CMP_HIDDEN, NSA_DH), CMP_HIDDEN),
        "w_nsa_up": nrm(ks[11], (L, NSA_QW, D_MODEL), NSA_QW),
        "w_out": nrm(ks[12], (L, D_MODEL, D_MODEL), D_MODEL),
        "norm2_w": 1.0 + 0.01 * jax.random.normal(ks[13], (L, D_MODEL), f32),
        "w_ffn_up": nrm(ks[14], (L, D_MODEL, 2 * D_FF), D_MODEL),
        "conv_w": nrm(ks[15], (L, CONV_W, 2 * D_FF), CONV_W),
        "conv_b": 0.01 * jax.random.normal(ks[16], (L, 2 * D_FF), f32),
        "w_ffn_down": nrm(ks[17], (L, D_FF, D_MODEL), D_FF),
        "final_norm_w": 1.0 + 0.01 * jax.random.normal(ks[18], (D_MODEL,), f32),
    }


def reference(x, norm1_w, w_in, ret_norm_w, w_ret_up, cmp_pe_k, cmp_w1_k, cmp_w2_k,
              cmp_pe_v, cmp_w1_v, cmp_w2_v, w_nsa_up, w_out, norm2_w, w_ffn_up,
              conv_w, conv_b, w_ffn_down, final_norm_w):
    B, S, _ = x.shape
    pos = jnp.arange(S, dtype=jnp.int32)

    def heads(t, n, d):
        return t.reshape(B, S, n, d).transpose(0, 2, 1, 3)

    h = x
    for l in range(DEPTH):
        xn = rmsnorm(h, norm1_w[l])
        proj = xn @ w_in[l]
        rq, rk, rv, rg, nq, nkv, ngate, mgate = jnp.split(proj, SPLIT_OFFSETS, axis=-1)
        rq = rotary(heads(rq, RET_HEADS, RET_DK), pos) * (RET_DK ** -0.5)
        rk = rotary(heads(rk, RET_HEADS, RET_DK), pos)
        ret = retention_chunkwise(rq, rk, heads(rv, RET_HEADS, RET_DV))
        ret = head_rmsnorm(ret).transpose(0, 2, 1, 3).reshape(B, S, RET_VW) * ret_norm_w[l]
        y_ret = (jax.nn.silu(rg) * ret) @ w_ret_up[l]
        kc, vc, ksl, vsl, kwn, vwn = [heads(t, NSA_GROUPS, NSA_DH) for t in jnp.split(nkv, 6, axis=-1)]
        br_gates = jax.nn.sigmoid(ngate).reshape(B, S, NSA_HEADS, 3).transpose(0, 2, 1, 3)
        nsa = native_sparse_attention(heads(nq, NSA_HEADS, NSA_DH), kc, vc, ksl, vsl, kwn, vwn, br_gates,
                                      cmp_pe_k[l], cmp_w1_k[l], cmp_w2_k[l],
                                      cmp_pe_v[l], cmp_w1_v[l], cmp_w2_v[l])
        y_nsa = nsa @ w_nsa_up[l]
        g_ret, g_nsa = jnp.split(jax.nn.sigmoid(mgate), 2, axis=-1)
        h = h + (g_ret * y_ret + g_nsa * y_nsa) @ w_out[l]
        xn = rmsnorm(h, norm2_w[l])
        u = causal_dwconv(xn @ w_ffn_up[l], conv_w[l], conv_b[l])
        a, b = jnp.split(u, 2, axis=-1)
        h = h + (jax.nn.silu(a) * b) @ w_ffn_down[l]
    return rmsnorm(h, final_norm_w)
```

```cpp
#include <hip/hip_runtime.h>
#include <hip/hip_cooperative_groups.h>
#include <cstdio>
#include <cstdint>
namespace cg = cooperative_groups;

#ifndef STAGE
#define STAGE 3
#endif

#define LAS __attribute__((address_space(3)))
typedef unsigned short bf16_t;
typedef short bf16x8 __attribute__((ext_vector_type(8)));
typedef short s16x4 __attribute__((ext_vector_type(4)));
typedef float f32x4 __attribute__((ext_vector_type(4)));
typedef float f32x16 __attribute__((ext_vector_type(16)));
typedef unsigned u32x4 __attribute__((ext_vector_type(4)));
typedef unsigned u32x2 __attribute__((ext_vector_type(2)));
typedef __bf16 bf16v2 __attribute__((ext_vector_type(2)));
typedef float f32v2 __attribute__((ext_vector_type(2)));
#define DI __device__ __forceinline__
#define LDS_WAIT() asm volatile("s_waitcnt lgkmcnt(0)" ::: "memory")
#define MFMA32(a, b, c) __builtin_amdgcn_mfma_f32_32x32x16_bf16((a), (b), (c), 0, 0, 0)
#define MFMA16(a, b, c) __builtin_amdgcn_mfma_f32_16x16x32_bf16((a), (b), (c), 0, 0, 0)

constexpr int DM = 2048, SEQ = 4096, MTOK = 16384, MH = 8192;
constexpr int NCOL = 13872, LDP = 14080;
constexpr int C_RQ = 0, C_RK = 1024, C_RV = 2048, C_RG = 4096, C_NQ = 6144, C_KC = 8192, C_VC = 8448, C_KS = 8704, C_VS = 8960,
              C_KW = 9216, C_VW = 9472, C_NG = 9728, C_MG = 9776;
constexpr int DFF = 5632, DFF2 = 11264;
constexpr float EPS = 1e-6f;
constexpr size_t MiB = 1u << 20;
constexpr size_t WS_WIN = 1 * MiB, WS_WRET = 56 * MiB, WS_WNSA = 64 * MiB, WS_WOUT = 72 * MiB, WS_W1K = 80 * MiB, WS_W1V = 82 * MiB,
                 WS_W2K = 84 * MiB, WS_W2V = 84 * MiB + 65536, WS_ROTC = 85 * MiB, WS_ROTS = 86 * MiB, WS_KCMP = 87 * MiB, WS_VCMPT = 87 * MiB + 524288,
                 WS_SEL = 88 * MiB, WS_XN = 90 * MiB  , WS_PROJ = 122 * MiB, WS_NSA = 342 * MiB, WS_KT = 374 * MiB, WS_VT = 390 * MiB,
                 WS_STATE = 422 * MiB, WS_MX = 374 * MiB  ,
                 WS_WUP = 90 * MiB, WS_WDOWN = 134 * MiB, WS_XN2 = 156 * MiB, WS_U = 220 * MiB, WS_ACT = 396 * MiB, WS_END = 484 * MiB;
constexpr int LDS_BYTES = 143360;
constexpr int NT = 512;

DI unsigned pk2(float lo, float hi) { f32v2 v = {lo, hi}; bf16v2 b = __builtin_convertvector(v, bf16v2); return __builtin_bit_cast(unsigned, b); }
DI float bf2f(unsigned short b) { return __uint_as_float(((unsigned)b) << 16); }
DI float bflo(unsigned w) { return __uint_as_float(w << 16); }
DI float bfhi(unsigned w) { return __uint_as_float(w & 0xffff0000u); }
DI bf16x8 pack8(f32x4 a, f32x4 b) { u32x4 w = {pk2(a[0], a[1]), pk2(a[2], a[3]), pk2(b[0], b[1]), pk2(b[2], b[3])}; return __builtin_bit_cast(bf16x8, w); }
DI float sigmoidf_(float x) { return 1.f / (1.f + __expf(-x)); }
DI float siluf_(float x) { return x / (1.f + __expf(-x)); }
template <int M> DI float swz(float v) { return __int_as_float(__builtin_amdgcn_ds_swizzle(__float_as_int(v), (M << 10) | 0x1F)); }
template <int M> DI unsigned swzu(unsigned v) { return (unsigned)__builtin_amdgcn_ds_swizzle((int)v, (M << 10) | 0x1F); }
DI float xor32(float v, int hi) { auto rr = __builtin_amdgcn_permlane32_swap(__float_as_uint(v), __float_as_uint(v), false, false); return __uint_as_float(hi ? rr[0] : rr[1]); }
DI float sum32(float v) { auto rr = __builtin_amdgcn_permlane32_swap(__float_as_uint(v), __float_as_uint(v), false, false); return __uint_as_float(rr[0]) + __uint_as_float(rr[1]); }
DI float wave_sum(float v) { v += swz<1>(v); v += swz<2>(v); v += swz<4>(v); v += swz<8>(v); v += swz<16>(v); return sum32(v); }
DI void grid_bar(unsigned* bar, unsigned& epoch, int G, int wv) {
    asm volatile("s_waitcnt vmcnt(0)" ::: "memory");
    __syncthreads();
    const int t = (wv << 6) | (int)__builtin_amdgcn_mbcnt_hi(~0u, __builtin_amdgcn_mbcnt_lo(~0u, 0u));
    epoch += 1u;
    if (t == 0) {
        __builtin_amdgcn_fence(__ATOMIC_RELEASE, "agent");
        asm volatile("s_waitcnt vmcnt(0)" ::: "memory");
        __hip_atomic_fetch_add(bar, 1u, __ATOMIC_RELAXED, __HIP_MEMORY_SCOPE_AGENT);
        const unsigned target = epoch * (unsigned)G;
        while (__hip_atomic_load(bar, __ATOMIC_RELAXED, __HIP_MEMORY_SCOPE_AGENT) < target) __builtin_amdgcn_s_sleep(2);
        __builtin_amdgcn_fence(__ATOMIC_ACQUIRE, "agent");
        asm volatile("s_waitcnt vmcnt(0)" ::: "memory");
    }
    __syncthreads();
}
DI int tid_(int wv) { int t = (wv << 6) | (int)__builtin_amdgcn_mbcnt_hi(~0u, __builtin_amdgcn_mbcnt_lo(~0u, 0u)); asm volatile("" : "+v"(t)); return t; }
template <class T> DI T* lnd(T* p) { asm volatile("" : "+s"(p)); return p; }
DI int crow(int r, int hi) { return (r & 3) + 8 * (r >> 2) + 4 * hi; }
DI float log2gamma(int h) { return log2f(1.0f - exp2f(-5.0f - (float)h)); }

namespace pg8 {
constexpr int BM = 256, BK = 64, HALF = 128, HTB = HALF * BK * 2, STAGE_BYTES = 8 * HTB, NXCD = 8, WGM = 8;
DI int lds_byte(int r, int c) { const int st = (r >> 4) * 2 + (c >> 5), rr = r & 15, cc = c & 31, ob = rr * 64 + cc * 2; return st * 1024 + (ob ^ (((ob >> 9) & 1) << 5)); }
DI void stage_rc(int b, int& R, int& C) { const int st = b / 1024, sb = b % 1024, swz = sb ^ (((sb >> 9) & 1) << 5); R = (st >> 1) * 16 + swz / 64; C = (st & 1) * 32 + (swz % 64) / 2; }
DI int perm32(int rho) { const int n = rho >> 4, i = rho & 15; return 8 * (i >> 2) + 4 * n + (i & 3); }
struct Unit { int pm, pn; };
struct Gemm { const bf16_t* A; const bf16_t* Bt; int M, N, K; };
struct StaticOrder {
    int nM, nN, nwg, G, c;
    DI void init(int M, int N, int G_, int c_) { nM = M / BM; nN = N / BM; nwg = nM * nN; G = G_; c = c_; }
    DI bool next(int i, Unit& u) const {
        const long L = (long)i * G + c; if (L >= nwg) return false;
        int wgid = (int)L; { const int q = nwg / NXCD, r = nwg % NXCD, xcd = wgid % NXCD, off = wgid / NXCD; wgid = (xcd < r ? xcd * (q + 1) : r * (q + 1) + (xcd - r) * q) + off; }
        const int nig = WGM * nN, gid = wgid / nig, fm = gid * WGM, gsz = (nM - fm) < WGM ? (nM - fm) : WGM;
        u.pm = fm + ((wgid % nig) % gsz); u.pn = (wgid % nig) / gsz; return true;
    }
};
template <int MODE> struct Epi {
    void* out; int ldo; const void* aux; int ldaux; const void* aux2; int ldaux2;
    DI void operator()(const f32x4 (&acc)[2][2][4][2], const Unit& u, int wr, int wc, int fr, int fq) const {
        const int row0 = u.pm * BM + wr * 64 + fr, col0 = u.pn * BM + wc * 32 + 8 * fq;
#pragma unroll
        for (int ai = 0; ai < 2; ++ai)
#pragma unroll
            for (int m = 0; m < 4; ++m) {
                const size_t row = (size_t)(row0 + ai * HALF + m * 16);
#pragma unroll
                for (int bj = 0; bj < 2; ++bj) {
                    const int col = col0 + bj * HALF;
                    f32x4 v0 = acc[ai][bj][m][0], v1 = acc[ai][bj][m][1];
                    if constexpr (MODE == 0) {
                        u32x4 w = {pk2(v0[0], v0[1]), pk2(v0[2], v0[3]), pk2(v1[0], v1[1]), pk2(v1[2], v1[3])};
                        *(u32x4*)((bf16_t*)out + row * ldo + col) = w;
                    } else if constexpr (MODE == 1 || MODE == 2) {
                        const u32x4 g = *(const u32x4*)((const bf16_t*)aux + row * ldaux + col);
                        f32x4 g0 = {sigmoidf_(bflo(g[0])), sigmoidf_(bfhi(g[0])), sigmoidf_(bflo(g[1])), sigmoidf_(bfhi(g[1]))};
                        f32x4 g1 = {sigmoidf_(bflo(g[2])), sigmoidf_(bfhi(g[2])), sigmoidf_(bflo(g[3])), sigmoidf_(bfhi(g[3]))};
                        v0 = v0 * g0; v1 = v1 * g1;
                        if constexpr (MODE == 1) { float* o = (float*)out + row * ldo + col; *(f32x4*)o = v0; *(f32x4*)(o + 4) = v1; }
                        else { const float* t = (const float*)aux2 + row * ldaux2 + col; v0 = v0 + *(const f32x4*)t; v1 = v1 + *(const f32x4*)(t + 4);
                            u32x4 w = {pk2(v0[0], v0[1]), pk2(v0[2], v0[3]), pk2(v1[0], v1[1]), pk2(v1[2], v1[3])};
                            *(u32x4*)((bf16_t*)out + row * ldo + col) = w; }
                    } else if constexpr (MODE == 3) {
                        const float* x = (const float*)aux + row * ldaux + col; float* o = (float*)out + row * ldo + col;
                        *(f32x4*)o = v0 + *(const f32x4*)x; *(f32x4*)(o + 4) = v1 + *(const f32x4*)(x + 4);
                    } else {
                        float* o = (float*)out + row * ldo + col;
                        *(f32x4*)o = v0 + *(const f32x4*)o; *(f32x4*)(o + 4) = v1 + *(const f32x4*)(o + 4);
                    }
                }
            }
    }
};

template <class EpiT>
DI void gemm_phase(LAS unsigned char* lds, const Gemm g, const StaticOrder& S, const EpiT& E, int wv) {
    const int tid = tid_(wv), wid = __builtin_amdgcn_readfirstlane(tid >> 6), lane = tid & 63, wr = wid >> 2, wc = wid & 3, fr = lane & 15, fq = lane >> 4;
    int K = g.K; const char* gA = (const char*)g.A; const char* gB = (const char*)g.Bt;
    asm volatile("" : "+s"(K), "+s"(gA), "+s"(gB));
    const int nt = K / BK;
    unsigned voffA[2], voffB[2];
#pragma unroll
    for (int i = 0; i < 2; ++i) { int R, C; stage_rc(tid * 16 + i * 8192, R, C); const int Rb = (R & ~31) + perm32(R & 31);
        voffA[i] = (unsigned)(R * K + C) * 2u; voffB[i] = (unsigned)(Rb * K + C) * 2u; }
    const size_t kstep = (size_t)(BK * 2);
    const size_t hstep = (size_t)HALF * K * 2;
    const size_t tstep = 2 * hstep;
    const unsigned ldsw = (unsigned)wid * 1024u;
    const int aoff = lds_byte(wr * 64 + fr, fq * 8), boff = lds_byte(wc * 32 + fr, fq * 8);
#define PG8_SA(b, h) (((b) * 2 + (h)) * HTB)
#define PG8_SB(b, h) ((4 + (b) * 2 + (h)) * HTB)
#define PG8_STAGE(bufoff, gbase, voff) do { _Pragma("unroll") for (int _i = 0; _i < 2; ++_i) \
        __builtin_amdgcn_global_load_lds((const unsigned*)((const char*)(gbase) + (voff)[_i]), (LAS unsigned*)(lds + (bufoff) + ldsw + _i * 8192), 16, 0, 0); } while (0)
#define PG8_LDA(dst, b, h) do { _Pragma("unroll") for (int m = 0; m < 4; ++m) _Pragma("unroll") for (int k = 0; k < 2; ++k) dst[m][k] = *(const LAS bf16x8*)(lds + PG8_SA(b, h) + aoff + m * 2048 + k * 1024); } while (0)
#define PG8_LDB(dst, b, h) do { _Pragma("unroll") for (int n = 0; n < 2; ++n) _Pragma("unroll") for (int k = 0; k < 2; ++k) dst[n][k] = *(const LAS bf16x8*)(lds + PG8_SB(b, h) + boff + n * 2048 + k * 1024); } while (0)
#define PG8_MMA(ai, bj, At, Bt) do { __builtin_amdgcn_s_setprio(1); _Pragma("unroll") for (int m = 0; m < 4; ++m) _Pragma("unroll") for (int n = 0; n < 2; ++n) _Pragma("unroll") for (int k = 0; k < 2; ++k) \
        acc[ai][bj][m][n] = __builtin_amdgcn_mfma_f32_16x16x32_bf16(Bt[n][k], At[m][k], acc[ai][bj][m][n], 0, 0, 0); __builtin_amdgcn_s_setprio(0); } while (0)
#define PG8_WAIT_V(n) asm volatile("s_waitcnt vmcnt(" #n ")" ::: "memory")
#define PG8_WAIT_L(n) asm volatile("s_waitcnt lgkmcnt(" #n ")" ::: "memory")
#define PG8_BAR __builtin_amdgcn_s_barrier()
#define PG8_SCHED __builtin_amdgcn_sched_barrier(0)
    Unit cur, nxt; int ui = 0;
    if (!S.next(0, cur)) return;
    f32x4 acc[2][2][4][2];
#pragma unroll
    for (int a = 0; a < 2; ++a)
#pragma unroll
        for (int b = 0; b < 2; ++b)
#pragma unroll
            for (int m = 0; m < 4; ++m)
#pragma unroll
                for (int n = 0; n < 2; ++n) acc[a][b][m][n] = (f32x4){0.f, 0.f, 0.f, 0.f};
    bf16x8 At[4][2], B0[2][2], B1[2][2];
    const char* cA = gA + (size_t)cur.pm * tstep; const char* cB = gB + (size_t)cur.pn * tstep;
    PG8_STAGE(PG8_SB(0, 0), cB, voffB); PG8_STAGE(PG8_SA(0, 0), cA, voffA); PG8_STAGE(PG8_SB(0, 1), cB + hstep, voffB); PG8_STAGE(PG8_SA(0, 1), cA + hstep, voffA);
    if (wr == 1) PG8_BAR;
    PG8_WAIT_V(4); PG8_BAR;
    PG8_STAGE(PG8_SB(1, 0), cB + kstep, voffB); PG8_STAGE(PG8_SA(1, 0), cA + kstep, voffA); PG8_STAGE(PG8_SB(1, 1), cB + hstep + kstep, voffB);
    PG8_WAIT_V(6); PG8_BAR;
    for (;;) {
        const bool has_next = S.next(ui + 1, nxt);
        const char* nA = has_next ? gA + (size_t)nxt.pm * tstep : cA; const char* nB = has_next ? gB + (size_t)nxt.pn * tstep : cB;
        for (int t = 0; t < nt; t += 2) {
            const bool last = (t == nt - 2);
            const char* a1 = cA + (size_t)(t + 1) * kstep;
            const char* a2 = last ? nA : cA + (size_t)(t + 2) * kstep; const char* b2 = last ? nB : cB + (size_t)(t + 2) * kstep;
            const char* a3 = a2 + kstep; const char* b3 = b2 + kstep;
            PG8_LDB(B0, 0, 0); PG8_SCHED; PG8_LDA(At, 0, 0); PG8_STAGE(PG8_SA(1, 1), a1 + hstep, voffA);
            PG8_WAIT_L(8); PG8_BAR; PG8_WAIT_L(0); PG8_MMA(0, 0, At, B0); PG8_BAR; PG8_SCHED;
            PG8_LDB(B1, 0, 1); PG8_STAGE(PG8_SB(0, 0), b2, voffB);
            PG8_BAR; PG8_WAIT_L(0); PG8_MMA(0, 1, At, B1); PG8_BAR;
            PG8_LDA(At, 0, 1); PG8_STAGE(PG8_SA(0, 0), a2, voffA);
            PG8_BAR; PG8_WAIT_L(0); PG8_MMA(1, 0, At, B0); PG8_BAR; PG8_SCHED;
            PG8_STAGE(PG8_SB(0, 1), b2 + hstep, voffB);
            PG8_WAIT_V(6); PG8_BAR; PG8_MMA(1, 1, At, B1); PG8_BAR;
            PG8_LDB(B0, 1, 0); PG8_SCHED; PG8_LDA(At, 1, 0); PG8_STAGE(PG8_SA(0, 1), a2 + hstep, voffA);
            PG8_WAIT_L(8); PG8_BAR; PG8_WAIT_L(0); PG8_MMA(0, 0, At, B0); PG8_BAR; PG8_SCHED;
            PG8_LDB(B1, 1, 1); PG8_STAGE(PG8_SB(1, 0), b3, voffB);
            PG8_BAR; PG8_WAIT_L(0); PG8_MMA(0, 1, At, B1); PG8_BAR;
            PG8_LDA(At, 1, 1); PG8_STAGE(PG8_SA(1, 0), a3, voffA);
            PG8_BAR; PG8_WAIT_L(0); PG8_MMA(1, 0, At, B0); PG8_BAR; PG8_SCHED;
            PG8_STAGE(PG8_SB(1, 1), b3 + hstep, voffB);
            PG8_WAIT_V(6); PG8_BAR; PG8_MMA(1, 1, At, B1); PG8_BAR;
        }
        E(acc, cur, wr, wc, fr, fq);
        if (!has_next) break;
#pragma unroll
        for (int a = 0; a < 2; ++a)
#pragma unroll
            for (int b = 0; b < 2; ++b)
#pragma unroll
                for (int m = 0; m < 4; ++m)
#pragma unroll
                    for (int n = 0; n < 2; ++n) acc[a][b][m][n] = (f32x4){0.f, 0.f, 0.f, 0.f};
        cur = nxt; cA = nA; cB = nB; ++ui;
    }
    PG8_WAIT_V(0);
    if (wr == 0) PG8_BAR;
    PG8_BAR;
#undef PG8_SA
#undef PG8_SB
#undef PG8_STAGE
#undef PG8_LDA
#undef PG8_LDB
#undef PG8_MMA
#undef PG8_WAIT_V
#undef PG8_WAIT_L
#undef PG8_BAR
#undef PG8_SCHED
}
}

DI void transpose_item(const float* W, int K, int N, bf16_t* WT, LAS float* scr, int item, int nblk, int lane) {
    const int kb = item / nblk, nb = item % nblk, k0 = 64 * kb, n0 = 32 * nb;
    const int nn = n0 + (lane & 31);
#pragma unroll 8
    for (int i = 0; i < 32; ++i) { const int kk = 2 * i + (lane >> 5); scr[kk * 33 + (lane & 31)] = nn < N ? W[(size_t)(k0 + kk) * N + nn] : 0.f; }
    LDS_WAIT();
    const int c = lane & 7;
#pragma unroll
    for (int j = 0; j < 4; ++j) { const int n = (lane >> 3) + 8 * j; const LAS float* s = scr + (8 * c) * 33 + n;
        u32x4 o; o.x = pk2(s[0 * 33], s[1 * 33]); o.y = pk2(s[2 * 33], s[3 * 33]); o.z = pk2(s[4 * 33], s[5 * 33]); o.w = pk2(s[6 * 33], s[7 * 33]);
        *(u32x4*)(WT + (size_t)(n0 + n) * K + k0 + 8 * c) = o; }
    LDS_WAIT();
}
DI void rms_row_bf16(const float* xrow, const float* w, bf16_t* orow, int lane) {
    const f32x4* xr = (const f32x4*)xrow + lane; const f32x4* wr = (const f32x4*)w + lane;
    f32x4 v[8]; float s = 0.f;
#pragma unroll
    for (int j = 0; j < 8; ++j) { v[j] = xr[64 * j]; s += (v[j].x * v[j].x + v[j].y * v[j].y) + (v[j].z * v[j].z + v[j].w * v[j].w); }
    const float rstd = rsqrtf(wave_sum(s) * (1.f / DM) + EPS);
    u32x2* o8 = (u32x2*)orow + lane;
#pragma unroll
    for (int j = 0; j < 8; ++j) { const f32x4 ww = wr[64 * j]; u32x2 o = {pk2(v[j].x * rstd * ww.x, v[j].y * rstd * ww.y), pk2(v[j].z * rstd * ww.z, v[j].w * rstd * ww.w)}; o8[64 * j] = o; }
}
DI void rms_row_f32(float* xrow, const float* w, int lane) {
    f32x4* xr = (f32x4*)xrow + lane; const f32x4* wr = (const f32x4*)w + lane;
    f32x4 v[8]; float s = 0.f;
#pragma unroll
    for (int j = 0; j < 8; ++j) { v[j] = xr[64 * j]; s += (v[j].x * v[j].x + v[j].y * v[j].y) + (v[j].z * v[j].z + v[j].w * v[j].w); }
    const float rstd = rsqrtf(wave_sum(s) * (1.f / DM) + EPS);
#pragma unroll
    for (int j = 0; j < 8; ++j) { const f32x4 ww = wr[64 * j]; xr[64 * j] = v[j] * rstd * ww; }
}

DI void rot_item(int item, bf16_t* PROJ, const float* ROTC, const float* ROTS, bf16_t* KT, bf16_t* VT, LAS unsigned char* lds, int wv) {
    const int tid = tid_(wv); PROJ = lnd(PROJ); ROTC = lnd(ROTC); ROTS = lnd(ROTS); KT = lnd(KT); VT = lnd(VT);
    const int bh = item >> 6, tb = item & 63, bl = bh >> 3, h = bh & 7;
    const int t0 = tb * 64;
    LAS bf16_t* ldsK = (LAS bf16_t*)lds;
    LAS bf16_t* ldsV = (LAS bf16_t*)(lds + 128 * 72 * 2);
    const float lg = log2gamma(h);
    {
        const int t = tid >> 3, seg = tid & 7, pos = t0 + t;
        bf16_t* prow = PROJ + (size_t)(bl * SEQ + pos) * LDP;
        const f32x4 c0 = *(const f32x4*)(ROTC + pos * 64 + seg * 8), c1 = *(const f32x4*)(ROTC + pos * 64 + seg * 8 + 4);
        const f32x4 s0 = *(const f32x4*)(ROTS + pos * 64 + seg * 8), s1 = *(const f32x4*)(ROTS + pos * 64 + seg * 8 + 4);
        const float cs[8] = {c0.x, c0.y, c0.z, c0.w, c1.x, c1.y, c1.z, c1.w}, sn[8] = {s0.x, s0.y, s0.z, s0.w, s1.x, s1.y, s1.z, s1.w};
        {
            bf16_t* p = prow + C_RQ + h * 128 + seg * 8;
            const u32x4 a = *(const u32x4*)p, b = *(const u32x4*)(p + 64);
            float o1[8], o2[8];
#pragma unroll
            for (int j = 0; j < 4; ++j) { const float x1l = bflo(a[j]), x1h = bfhi(a[j]), x2l = bflo(b[j]), x2h = bfhi(b[j]);
                o1[2 * j] = (x1l * cs[2 * j] - x2l * sn[2 * j]) * 0.08838834764831845f; o1[2 * j + 1] = (x1h * cs[2 * j + 1] - x2h * sn[2 * j + 1]) * 0.08838834764831845f;
                o2[2 * j] = (x1l * sn[2 * j] + x2l * cs[2 * j]) * 0.08838834764831845f; o2[2 * j + 1] = (x1h * sn[2 * j + 1] + x2h * cs[2 * j + 1]) * 0.08838834764831845f; }
            u32x4 w1 = {pk2(o1[0], o1[1]), pk2(o1[2], o1[3]), pk2(o1[4], o1[5]), pk2(o1[6], o1[7])}, w2 = {pk2(o2[0], o2[1]), pk2(o2[2], o2[3]), pk2(o2[4], o2[5]), pk2(o2[6], o2[7])};
            *(u32x4*)p = w1; *(u32x4*)(p + 64) = w2;
        }
        {
            bf16_t* p = prow + C_RK + h * 128 + seg * 8;
            const u32x4 a = *(const u32x4*)p, b = *(const u32x4*)(p + 64);
            float o1[8], o2[8];
#pragma unroll
            for (int j = 0; j < 4; ++j) { const float x1l = bflo(a[j]), x1h = bfhi(a[j]), x2l = bflo(b[j]), x2h = bfhi(b[j]);
                o1[2 * j] = x1l * cs[2 * j] - x2l * sn[2 * j]; o1[2 * j + 1] = x1h * cs[2 * j + 1] - x2h * sn[2 * j + 1];
                o2[2 * j] = x1l * sn[2 * j] + x2l * cs[2 * j]; o2[2 * j + 1] = x1h * sn[2 * j + 1] + x2h * cs[2 * j + 1]; }
            u32x4 w1 = {pk2(o1[0], o1[1]), pk2(o1[2], o1[3]), pk2(o1[4], o1[5]), pk2(o1[6], o1[7])}, w2 = {pk2(o2[0], o2[1]), pk2(o2[2], o2[3]), pk2(o2[4], o2[5]), pk2(o2[6], o2[7])};
            *(u32x4*)p = w1; *(u32x4*)(p + 64) = w2;
            const float kw = exp2f(lg * (float)(127 - (pos & 127)));
#pragma unroll
            for (int j = 0; j < 8; ++j) { ldsK[(seg * 8 + j) * 72 + t] = (bf16_t)(pk2(o1[j] * kw, 0.f) & 0xffffu); ldsK[(64 + seg * 8 + j) * 72 + t] = (bf16_t)(pk2(o2[j] * kw, 0.f) & 0xffffu); }
        }
        {
            const bf16_t* p = prow + C_RV + h * 256 + seg * 32;
#pragma unroll
            for (int q = 0; q < 4; ++q) { const u32x4 a = *(const u32x4*)(p + q * 8);
#pragma unroll
                for (int j = 0; j < 4; ++j) { ldsV[(seg * 32 + q * 8 + 2 * j) * 72 + t] = (bf16_t)(a[j] & 0xffffu); ldsV[(seg * 32 + q * 8 + 2 * j + 1) * 72 + t] = (bf16_t)(a[j] >> 16); } }
        }
    }
    __syncthreads();
    {
        const int d = tid >> 2, ts = (tid & 3) * 16;
        const u32x4 a = *(const LAS u32x4*)(ldsK + d * 72 + ts), b = *(const LAS u32x4*)(ldsK + d * 72 + ts + 8);
        bf16_t* o = KT + (size_t)(bh * 128 + d) * SEQ + t0 + ts; *(u32x4*)o = a; *(u32x4*)(o + 8) = b;
        const int e = tid >> 1, tv = (tid & 1) * 32;
        bf16_t* ov = VT + (size_t)(bh * 256 + e) * SEQ + t0 + tv;
#pragma unroll
        for (int q = 0; q < 4; ++q) *(u32x4*)(ov + q * 8) = *(const LAS u32x4*)(ldsV + e * 72 + tv + q * 8);
    }
    __syncthreads();
}

DI void retA_item(int item, const bf16_t* KT, const bf16_t* VT, bf16_t* STATE, int wv) {
    KT = lnd(KT); VT = lnd(VT); STATE = lnd(STATE);
    const int tid = tid_(wv), wid = tid >> 6, lane = tid & 63, r32 = lane & 31, hi = lane >> 5;
    const int bh = item >> 5, c = item & 31;
    const bf16_t* vp = VT + (size_t)(bh * 256 + wid * 32 + r32) * SEQ + c * 128 + hi * 8;
    const bf16_t* kp = KT + (size_t)(bh * 128 + r32) * SEQ + c * 128 + hi * 8;
    f32x16 acc[4] = {};
#pragma unroll
    for (int ks = 0; ks < 8; ++ks) {
        const bf16x8 a = *(const bf16x8*)(vp + ks * 16);
#pragma unroll
        for (int dt = 0; dt < 4; ++dt) { const bf16x8 b = *(const bf16x8*)(kp + (size_t)dt * 32 * SEQ + ks * 16); acc[dt] = MFMA32(a, b, acc[dt]); }
    }
    bf16_t* so = STATE + ((size_t)(bh * 32 + c) * 256 + wid * 32) * 128;
#pragma unroll
    for (int dt = 0; dt < 4; ++dt)
#pragma unroll
        for (int r = 0; r < 16; ++r) so[(size_t)crow(r, hi) * 128 + dt * 32 + r32] = (bf16_t)(pk2(acc[dt][r], 0.f) & 0xffffu);
}
DI void retB_scan(bf16_t* STATE, int gtid, int wv) {
    STATE = lnd(STATE);
    const int bh = gtid >> 13, rem = gtid & 8191;
    const float dec = exp2f(log2gamma(bh & 7) * 128.f);
    float s0 = 0.f, s1 = 0.f, s2 = 0.f, s3 = 0.f;
    bf16_t* p = STATE + (size_t)bh * 32 * 32768 + (size_t)rem * 4;
    for (int c = 0; c < 32; ++c) {
        u32x2* q = (u32x2*)(p + (size_t)c * 32768);
        const u32x2 kv = *q;
        u32x2 o = {pk2(s0, s1), pk2(s2, s3)}; *q = o;
        s0 = s0 * dec + bflo(kv[0]); s1 = s1 * dec + bfhi(kv[0]); s2 = s2 * dec + bflo(kv[1]); s3 = s3 * dec + bfhi(kv[1]);
    }
}
DI void retC_item(int item, const bf16_t* PROJ, const bf16_t* VT, const bf16_t* STATE, const float* ret_w, bf16_t* ARET, LAS unsigned char* lds, int wv) {
    PROJ = lnd(PROJ); VT = lnd(VT); STATE = lnd(STATE); ret_w = lnd(ret_w); ARET = lnd(ARET);
    const int tid = tid_(wv), wid = tid >> 6, lane = tid & 63, r32 = lane & 31, hi = lane >> 5;
    const int bh = item >> 5, c = item & 31, bl = bh >> 3, h = bh & 7;
    const int nb = wid & 3, eh = wid >> 2;
    const float lg = log2gamma(h);
    const size_t rowbase = (size_t)bl * SEQ + c * 128;
    const int ntok = nb * 32 + r32;
    bf16x8 qf[8];
    { const bf16_t* qp = PROJ + (rowbase + ntok) * LDP + C_RQ + h * 128 + hi * 8;
#pragma unroll
      for (int ds = 0; ds < 8; ++ds) qf[ds] = *(const bf16x8*)(qp + ds * 16); }
    f32x16 o[4] = {};
    const bf16_t* vbase = VT + (size_t)(bh * 256 + eh * 128 + r32) * SEQ + c * 128 + 4 * hi;
    for (int mb = 0; mb <= nb; ++mb) {
        f32x16 pt = {};
        const bf16_t* kp = PROJ + (rowbase + mb * 32 + r32) * LDP + C_RK + h * 128 + hi * 8;
#pragma unroll
        for (int ds = 0; ds < 8; ++ds) pt = MFMA32(*(const bf16x8*)(kp + ds * 16), qf[ds], pt);
#pragma unroll
        for (int r = 0; r < 16; ++r) { const int dd = ntok - (mb * 32 + crow(r, hi)); pt[r] = dd >= 0 ? pt[r] * exp2f(lg * (float)dd) : 0.f; }
#pragma unroll
        for (int s = 0; s < 2; ++s) {
            u32x4 pw = {pk2(pt[8 * s], pt[8 * s + 1]), pk2(pt[8 * s + 2], pt[8 * s + 3]), pk2(pt[8 * s + 4], pt[8 * s + 5]), pk2(pt[8 * s + 6], pt[8 * s + 7])};
            const bf16x8 pb = __builtin_bit_cast(bf16x8, pw);
#pragma unroll
            for (int et = 0; et < 4; ++et) {
                const bf16_t* vp = vbase + (size_t)et * 32 * SEQ + mb * 32 + s * 16;
                const u32x2 lo = *(const u32x2*)vp, hh = *(const u32x2*)(vp + 8);
                u32x4 aw = {lo[0], lo[1], hh[0], hh[1]};
                o[et] = MFMA32(__builtin_bit_cast(bf16x8, aw), pb, o[et]);
            }
        }
    }
    f32x16 cr[4] = {};
    { const bf16_t* sp = STATE + ((size_t)(bh * 32 + c) * 256 + eh * 128 + r32) * 128 + hi * 8;
#pragma unroll
      for (int ds = 0; ds < 8; ++ds)
#pragma unroll
          for (int et = 0; et < 4; ++et) cr[et] = MFMA32(*(const bf16x8*)(sp + (size_t)et * 32 * 128 + ds * 16), qf[ds], cr[et]); }
    const float qd = exp2f(lg * (float)(ntok + 1));
    float ss = 0.f;
#pragma unroll
    for (int et = 0; et < 4; ++et)
#pragma unroll
        for (int r = 0; r < 16; ++r) { const float v = o[et][r] + cr[et][r] * qd; o[et][r] = v; ss += v * v; }
    ss = sum32(ss);
    LAS float* ex = (LAS float*)lds;
    if (hi == 0) ex[wid * 32 + r32] = ss;
    __syncthreads();
    const float tot = ex[wid * 32 + r32] + ex[(wid ^ 4) * 32 + r32];
    const float rstd = rsqrtf(tot * (1.f / 256.f) + EPS);
    const size_t orow = rowbase + ntok;
    const bf16_t* rgp = PROJ + orow * LDP + C_RG + h * 256 + eh * 128;
    bf16_t* op = ARET + orow * DM + h * 256 + eh * 128;
    const float* wp = ret_w + h * 256 + eh * 128;
#pragma unroll
    for (int et = 0; et < 4; ++et)
#pragma unroll
        for (int q = 0; q < 4; ++q) {
            const int e = et * 32 + 8 * q + 4 * hi;
            const u32x2 g = *(const u32x2*)(rgp + e); const f32x4 w = *(const f32x4*)(wp + e);
            const float v0 = o[et][4 * q] * rstd * w.x * siluf_(bflo(g[0])), v1 = o[et][4 * q + 1] * rstd * w.y * siluf_(bfhi(g[0]));
            const float v2 = o[et][4 * q + 2] * rstd * w.z * siluf_(bflo(g[1])), v3 = o[et][4 * q + 3] * rstd * w.w * siluf_(bfhi(g[1]));
            u32x2 ow = {pk2(v0, v1), pk2(v2, v3)}; *(u32x2*)(op + e) = ow;
        }
    __syncthreads();
}

DI float gelu_tanh(float x) { const float u = 0.7978845608028654f * (x + 0.044715f * x * x * x); const float e = __expf(2.f * u); const float t = 1.f - 2.f / (e + 1.f); return 0.5f * x * (1.f + t); }
DI void cmp_item(int item, int hf, const bf16_t* PROJ, const float* pe_k, const float* pe_v, const bf16_t* W1K, const bf16_t* W1V, const bf16_t* W2K, const bf16_t* W2V,
                 bf16_t* KCMP, bf16_t* VCMPT, LAS unsigned char* lds, int wv) {
    PROJ = lnd(PROJ); KCMP = lnd(KCMP); VCMPT = lnd(VCMPT);
    const int tid = tid_(wv), wid = tid >> 6, lane = tid & 63, fr = lane & 15, kq = lane >> 4;
    const int rg = item & 15, g = (item >> 4) & 1, bl = (item >> 5) & 1, kv = item >> 6;
    const float* pe = lnd(kv ? pe_v : pe_k); const bf16_t* W1 = lnd(kv ? W1V : W1K); const bf16_t* W2 = lnd(kv ? W2V : W2K);
    const int ccol = (kv ? C_VC : C_KC) + g * 128;
    const int i_raw = rg * 16 + fr, ib = i_raw > 254 ? 254 : i_raw;
    const bf16_t* arow = PROJ + (size_t)(bl * SEQ + 16 * ib) * LDP + ccol + 8 * kq;
    const bf16_t* b0p = W1 + (size_t)(wid * 32 + fr) * 4096 + 8 * kq;
    const bf16_t* b1p = b0p + (size_t)16 * 4096;
    f32x4 acc0 = {0.f, 0.f, 0.f, 0.f}, acc1 = {0.f, 0.f, 0.f, 0.f};
#pragma unroll 4
    for (int ks = 0; ks < 128; ++ks) {
        const int l = ks >> 2, d0 = (ks & 3) * 32;
        const u32x4 xa = *(const u32x4*)(arow + (size_t)l * LDP + d0);
        const float* pp = pe + l * 128 + d0 + 8 * kq;
        const f32x4 p0 = *(const f32x4*)pp, p1 = *(const f32x4*)(pp + 4);
        u32x4 aw = {pk2(bflo(xa[0]) + p0.x, bfhi(xa[0]) + p0.y), pk2(bflo(xa[1]) + p0.z, bfhi(xa[1]) + p0.w), pk2(bflo(xa[2]) + p1.x, bfhi(xa[2]) + p1.y), pk2(bflo(xa[3]) + p1.z, bfhi(xa[3]) + p1.w)};
        const bf16x8 af = __builtin_bit_cast(bf16x8, aw);
        acc0 = MFMA16(af, *(const bf16x8*)(b0p + ks * 32), acc0);
        acc1 = MFMA16(af, *(const bf16x8*)(b1p + ks * 32), acc1);
    }
    LAS bf16_t* hid = (LAS bf16_t*)lds;
#pragma unroll
    for (int r = 0; r < 4; ++r) {
        hid[(4 * kq + r) * 264 + wid * 32 + fr] = (bf16_t)(pk2(gelu_tanh(acc0[r]), 0.f) & 0xffffu);
        hid[(4 * kq + r) * 264 + wid * 32 + 16 + fr] = (bf16_t)(pk2(gelu_tanh(acc1[r]), 0.f) & 0xffffu);
    }
    __syncthreads();
    f32x4 o = {0.f, 0.f, 0.f, 0.f};
    const bf16_t* w2p = W2 + (size_t)(wid * 16 + fr) * 256 + 8 * kq;
#pragma unroll
    for (int ks = 0; ks < 8; ++ks) o = MFMA16(*(const LAS bf16x8*)(hid + fr * 264 + ks * 32 + 8 * kq), *(const bf16x8*)(w2p + ks * 32), o);
    const int bg = (hf * 2 + bl) * 2 + g;
    const int d = wid * 16 + fr;
    if (kv == 0) {
#pragma unroll
        for (int r = 0; r < 4; ++r) { const int i = rg * 16 + 4 * kq + r; KCMP[((size_t)bg * 256 + i) * 128 + d] = i < 255 ? (bf16_t)(pk2(o[r], 0.f) & 0xffffu) : (bf16_t)0; }
    } else {
        const int i0 = rg * 16 + 4 * kq;
        u32x2 w = {pk2(o[0], o[1]), pk2(o[2], (i0 + 3 < 255) ? o[3] : 0.f)};
        *(u32x2*)(VCMPT + ((size_t)bg * 128 + d) * 256 + i0) = w;
    }
    __syncthreads();
}

DI void cattn_item(int item, int hf, const bf16_t* PROJ, const bf16_t* KCMP, const bf16_t* VCMPT, float* NSAF, unsigned* SEL, LAS unsigned char* lds, int wv) {
    PROJ = lnd(PROJ); KCMP = lnd(KCMP); VCMPT = lnd(VCMPT); NSAF = lnd(NSAF); SEL = lnd(SEL);
    const int tid = tid_(wv), wid = tid >> 6, lane = tid & 63, r32 = lane & 31, hi = lane >> 5;
    const int tb = item & 127, g = (item >> 7) & 1, bl = item >> 8;
    const int bg = (hf * 2 + bl) * 2 + g, head = g * 8 + wid;
    const int t = tb * 32 + r32;
    const size_t lrow = (size_t)bl * SEQ + t;
    const int ntile = (tb >> 4) + 1;
    bf16x8 qf[8];
    { const bf16_t* qp = PROJ + lrow * LDP + C_NQ + head * 128 + hi * 8;
#pragma unroll
      for (int ds = 0; ds < 8; ++ds) qf[ds] = *(const bf16x8*)(qp + ds * 16); }
    f32x16 s[8];
    const bf16_t* kb = KCMP + ((size_t)bg * 256 + r32) * 128 + hi * 8;
    const int imax = (t - 31) >> 4;
    float mx = -__builtin_inff();
#pragma unroll
    for (int kt = 0; kt < 8; ++kt) {
        s[kt] = f32x16{};
        if (kt < ntile) {
#pragma unroll
            for (int ds = 0; ds < 8; ++ds) s[kt] = MFMA32(*(const bf16x8*)(kb + (size_t)kt * 32 * 128 + ds * 16), qf[ds], s[kt]);
        }
#pragma unroll
        for (int r = 0; r < 16; ++r) { const int i = kt * 32 + crow(r, hi); const float v = (kt < ntile && i <= imax) ? s[kt][r] * 0.08838834764831845f : -__builtin_inff(); s[kt][r] = v; mx = fmaxf(mx, v); }
    }
    mx = fmaxf(mx, xor32(mx, hi));
    if (mx == -__builtin_inff()) mx = 0.f;
    float sum = 0.f;
#pragma unroll
    for (int kt = 0; kt < 8; ++kt)
#pragma unroll
        for (int r = 0; r < 16; ++r) { const float p = __expf(s[kt][r] - mx); s[kt][r] = p; sum += p; }
    sum = sum32(sum);
    const float inv = 1.f / fmaxf(sum, 1e-30f);
    f32x16 o[4] = {};
    const bf16_t* vb = VCMPT + ((size_t)bg * 128 + r32) * 256 + 4 * hi;
    LAS float* slab = (LAS float*)lds;
    float plprev = 0.f;
#pragma unroll
    for (int kt = 0; kt < 8; ++kt) {
#pragma unroll
        for (int r = 0; r < 16; ++r) s[kt][r] *= inv;
        if (kt < ntile) {
#pragma unroll
            for (int st = 0; st < 2; ++st) {
                u32x4 pw = {pk2(s[kt][8 * st], s[kt][8 * st + 1]), pk2(s[kt][8 * st + 2], s[kt][8 * st + 3]), pk2(s[kt][8 * st + 4], s[kt][8 * st + 5]), pk2(s[kt][8 * st + 6], s[kt][8 * st + 7])};
                const bf16x8 pb = __builtin_bit_cast(bf16x8, pw);
#pragma unroll
                for (int dt = 0; dt < 4; ++dt) {
                    const bf16_t* vp = vb + (size_t)dt * 32 * 256 + kt * 32 + st * 16;
                    const u32x2 lo = *(const u32x2*)vp, hh = *(const u32x2*)(vp + 8);
                    u32x4 aw = {lo[0], lo[1], hh[0], hh[1]};
                    o[dt] = MFMA32(__builtin_bit_cast(bf16x8, aw), pb, o[dt]);
                }
            }
        }
#pragma unroll
        for (int q = 0; q < 4; ++q) {
            const float gsum = (s[kt][4 * q] + s[kt][4 * q + 1]) + (s[kt][4 * q + 2] + s[kt][4 * q + 3]);
            const float pl = xor32(s[kt][4 * q + 3], hi);
            const float add = hi ? pl : plprev;
            slab[(wid * 32 + r32) * 65 + 8 * kt + 2 * q + hi] = gsum + add;
            plprev = pl;
        }
    }
    {
        const float gate = sigmoidf_(bf2f(PROJ[lrow * LDP + C_NG + head * 3 + 0]));
        float* op = NSAF + lrow * DM + head * 128;
#pragma unroll
        for (int dt = 0; dt < 4; ++dt)
#pragma unroll
            for (int q = 0; q < 4; ++q) { f32x4 v = {o[dt][4 * q] * gate, o[dt][4 * q + 1] * gate, o[dt][4 * q + 2] * gate, o[dt][4 * q + 3] * gate}; *(f32x4*)(op + dt * 32 + 8 * q + 4 * hi) = v; }
    }
    __syncthreads();
    LAS float* imps = (LAS float*)(lds + 8 * 32 * 65 * 4);
    const int c = tid >> 4, j4 = (tid & 15) * 4;
#pragma unroll
    for (int k = 0; k < 4; ++k) { float v = 0.f;
#pragma unroll
        for (int w = 0; w < 8; ++w) v += slab[(w * 32 + c) * 65 + j4 + k];
        imps[c * 65 + j4 + k] = v; }
    __syncthreads();
    {
        const int tt = tb * 32 + c, cur = tt >> 6;
        float myv[4];
#pragma unroll
        for (int k = 0; k < 4; ++k) { const int sb = j4 + k; myv[k] = (sb == 0 || sb == cur || sb == cur - 1) ? 1e4f : (sb > cur ? -1e4f : imps[c * 65 + sb]); }
        int rank[4] = {0, 0, 0, 0};
        for (int sb2 = 0; sb2 < 64; ++sb2) {
            const float v2 = (sb2 == 0 || sb2 == cur || sb2 == cur - 1) ? 1e4f : (sb2 > cur ? -1e4f : imps[c * 65 + sb2]);
#pragma unroll
            for (int k = 0; k < 4; ++k) rank[k] += (v2 > myv[k] || (v2 == myv[k] && sb2 < j4 + k)) ? 1 : 0;
        }
        unsigned lo = 0, hh = 0;
#pragma unroll
        for (int k = 0; k < 4; ++k) { const int sb = j4 + k; if (rank[k] < 16 && sb <= cur) { if (sb < 32) lo |= 1u << sb; else hh |= 1u << (sb - 32); } }
        lo |= swzu<1>(lo); hh |= swzu<1>(hh); lo |= swzu<2>(lo); hh |= swzu<2>(hh); lo |= swzu<4>(lo); hh |= swzu<4>(hh); lo |= swzu<8>(lo); hh |= swzu<8>(hh);
        if ((tid & 15) == 0) { u32x2 w = {lo, hh}; *(u32x2*)(SEL + ((size_t)bg * SEQ + tt) * 2) = w; }
    }
    __syncthreads();
}

namespace att {
constexpr float SCALE = 0.08838834764831845f;
constexpr int NW = 8, QBLK = 32, KVBLK = 64, QB = 256, D = 128;
constexpr int SHM_V = KVBLK * D * 2, SHM_K = KVBLK * D * 2;
constexpr int LDS_NEED = 2 * SHM_V + 2 * SHM_K + NW * 64 * 4;
constexpr float THR = 8.f;
#define KSWZ(row, colB) ((row) * 256 + ((colB) ^ (((row) & 7) << 4)))
#define SBAR() __builtin_amdgcn_sched_barrier(0)
DI int v_st(int k, int c) { const int kk = (k & ~0xC) | ((k & 4) << 1) | ((k & 8) >> 1); return ((kk >> 3) * 4 + (c >> 5)) * 512 + ((kk & 7) * 32 + (c & 31)) * 2; }
DI int v_rd_base(int lane) { return ((lane & 3) << 3) | (((lane >> 2) & 3) << 6) | (((lane >> 4) & 1) << 5) | (((lane >> 5) & 1) << 8); }
constexpr int v_rd_off(int d0, int ks, int half) { return d0 * 512 + ks * 4096 + half * 2048; }
DI unsigned cvtpk(float lo, float hi) { unsigned r; asm volatile("v_cvt_pk_bf16_f32 %0, %1, %2" : "=v"(r) : "v"(lo), "v"(hi)); return r; }
DI bf16x8 load8(const bf16_t* p) { return *reinterpret_cast<const bf16x8*>(p); }
DI void mask_tile(f32x16& p0, f32x16& p1, int dq, unsigned W) {
    const float NEG = -__builtin_inff();
#pragma unroll
    for (int r = 0; r < 16; ++r) {
        const int c = (r & 3) + 8 * (r >> 2);
        if ((unsigned)(dq - c) >= W) p0[r] = NEG;
        if ((unsigned)(dq - c - 32) >= W) p1[r] = NEG;
    }
}
DI void partialSM(f32x16& p0, f32x16& p1, float& m_reg, float& mn, float& alpha) {
    float pmax = p0[0]; for (int r = 1; r < 16; ++r) pmax = fmaxf(pmax, p0[r]); for (int r = 0; r < 16; ++r) pmax = fmaxf(pmax, p1[r]);
    { auto rr = __builtin_amdgcn_permlane32_swap(__float_as_uint(pmax), __float_as_uint(pmax), false, false);
      pmax = fmaxf(__uint_as_float(rr[0]), __uint_as_float(rr[1])); }
    constexpr float C2 = 1.4426950408889634f * SCALE;
    if (__builtin_expect(__all((pmax - m_reg) * SCALE <= THR), 1)) { mn = m_reg; alpha = 1.f; }
    else { mn = fmaxf(m_reg, pmax); alpha = __builtin_amdgcn_exp2f((m_reg - mn) * C2); m_reg = mn; }
    const float mnL = -mn * C2;
    for (int r = 0; r < 16; ++r) p0[r] = fmaf(p0[r], C2, mnL); for (int r = 0; r < 16; ++r) p1[r] = fmaf(p1[r], C2, mnL);
    for (int r = 0; r < 16; ++r) p0[r] = __builtin_amdgcn_exp2f(p0[r]);
}
DI void finishSM(f32x16& p0, f32x16& p1, float alpha, float& l_reg, bf16x8& pa0, bf16x8& pa1, bf16x8& pa2, bf16x8& pa3) {
    for (int r = 0; r < 16; ++r) p1[r] = __builtin_amdgcn_exp2f(p1[r]);
    float ps = 0; for (int r = 0; r < 16; ++r) ps += p0[r]; for (int r = 0; r < 16; ++r) ps += p1[r];
    { auto rr = __builtin_amdgcn_permlane32_swap(__float_as_uint(ps), __float_as_uint(ps), false, false);
      ps = __uint_as_float(rr[0]) + __uint_as_float(rr[1]); }
    l_reg = l_reg * alpha + ps;
#define PK4(P, B_, OUT) do { unsigned a0 = cvtpk(P[B_+0], P[B_+1]), a1 = cvtpk(P[B_+2], P[B_+3]);                          \
        unsigned b0 = cvtpk(P[B_+4], P[B_+5]), b1 = cvtpk(P[B_+6], P[B_+7]);                                             \
        auto r0 = __builtin_amdgcn_permlane32_swap(a0, b0, false, false); auto r1 = __builtin_amdgcn_permlane32_swap(a1, b1, false, false); \
        u32x4 w = {r0[0], r1[0], r0[1], r1[1]}; OUT = *reinterpret_cast<bf16x8*>(&w); } while (0)
    PK4(p0, 0, pa0); PK4(p0, 8, pa1); PK4(p1, 0, pa2); PK4(p1, 8, pa3);
#undef PK4
}
template <int KB>
DI void qkt(f32x16& p0, f32x16& p1, const char* K_lds, int r32, int hi, const bf16x8* qr) {
    p0 = f32x16{}; p1 = f32x16{};
    const char* kb[4];
#pragma unroll
    for (int dd = 0; dd < 4; ++dd) kb[dd] = K_lds + KB * SHM_K + KSWZ(r32, (dd * 16 + hi * 8) * 2);
#pragma unroll
    for (int d0 = 0; d0 < 8; ++d0) { const char* a = kb[d0 & 3] + (d0 >> 2) * 128;
        bf16x8 b0 = *reinterpret_cast<const bf16x8*>(a);
        bf16x8 b1 = *reinterpret_cast<const bf16x8*>(a + 32 * 256);
        p0 = __builtin_amdgcn_mfma_f32_32x32x16_bf16(b0, qr[d0], p0, 0, 0, 0);
        p1 = __builtin_amdgcn_mfma_f32_32x32x16_bf16(b1, qr[d0], p1, 0, 0, 0); }
}
template <int VB>
DI void pv_tile(f32x16* o, int vb0, bf16x8 pa0, bf16x8 pa1, bf16x8 pa2, bf16x8 pa3) {
#define TRRD(dst, off) asm volatile("ds_read_b64_tr_b16 %0, %1 offset:%2" : "=&v"(dst) : "v"(vb0), "i"(off) : "memory")
#define PV_D0(d0) do { s16x4 l0, l1, l2, l3, h0, h1, h2, h3; constexpr int b_ = VB * SHM_V + v_rd_off(d0, 0, 0); \
        TRRD(l0, b_); TRRD(h0, b_ + 2048); TRRD(l1, b_ + 4096); TRRD(h1, b_ + 6144); TRRD(l2, b_ + 8192); TRRD(h2, b_ + 10240); TRRD(l3, b_ + 12288); TRRD(h3, b_ + 14336); \
        asm volatile("s_waitcnt lgkmcnt(0)" ::: "memory"); SBAR();   \
        o[d0] = __builtin_amdgcn_mfma_f32_32x32x16_bf16(pa0, (bf16x8){l0[0], l0[1], l0[2], l0[3], h0[0], h0[1], h0[2], h0[3]}, o[d0], 0, 0, 0);   \
        o[d0] = __builtin_amdgcn_mfma_f32_32x32x16_bf16(pa1, (bf16x8){l1[0], l1[1], l1[2], l1[3], h1[0], h1[1], h1[2], h1[3]}, o[d0], 0, 0, 0);   \
        o[d0] = __builtin_amdgcn_mfma_f32_32x32x16_bf16(pa2, (bf16x8){l2[0], l2[1], l2[2], l2[3], h2[0], h2[1], h2[2], h2[3]}, o[d0], 0, 0, 0);   \
        o[d0] = __builtin_amdgcn_mfma_f32_32x32x16_bf16(pa3, (bf16x8){l3[0], l3[1], l3[2], l3[3], h3[0], h3[1], h3[2], h3[3]}, o[d0], 0, 0, 0); } while (0)
    PV_D0(0); PV_D0(1); PV_D0(2); PV_D0(3);
#undef PV_D0
#undef TRRD
}
struct BlockRef { const bf16_t* Q; const bf16_t* K; const bf16_t* V; float* Of; bf16_t* Ob; const unsigned* sel; const bf16_t* gate; int P0; int W; int mode; };
struct Seam { bf16x8 qr[8]; bf16x8 st_v0, st_v1, st_k0, st_k1; };
DI int swa_jlo(int P0, int W) { const int lowk = P0 - W + 1; return lowk > 0 ? lowk / KVBLK : 0; }
#define ROW(p, k0, rr) ((p) + (size_t)((k0) + (rr)) * LDP + sc)
#define VMW() asm volatile("s_waitcnt vmcnt(0)" ::: "memory")
#define VMWN(n) asm volatile("s_waitcnt vmcnt(%0)" :: "i"(n) : "memory")
#define SLOAD_H(Kp, Vp, k0) do { S.st_v0 = load8(ROW(Vp, k0, sr)); S.st_v1 = load8(ROW(Vp, k0, 32 + sr));              \
                         S.st_k0 = load8(ROW(Kp, k0, sr)); S.st_k1 = load8(ROW(Kp, k0, 32 + sr)); } while (0)
#define SWRITE_HK(bf) do { *(bf16x8*)(K_lds + (bf) * SHM_K + kws) = S.st_k0; *(bf16x8*)(K_lds + (bf) * SHM_K + kws + 32 * 256) = S.st_k1; } while (0)
#define SWRITE_HV(bf) do { *(bf16x8*)(V_lds + (bf) * SHM_V + vst0) = S.st_v0; *(bf16x8*)(V_lds + (bf) * SHM_V + vst1) = S.st_v1; } while (0)
#define SWRITE_H(bf) do { SWRITE_HV(bf); SWRITE_HK(bf); } while (0)
DI void prime(const BlockRef& cur, char* lds, Seam& S, int wv) {
    const int tid = tid_(wv), wid = __builtin_amdgcn_readfirstlane(tid >> 6), lane = tid & 63, r32 = lane & 31, hi = lane >> 5;
    const int sr = tid >> 4, sc = (tid & 15) * 8, kws = KSWZ(sr, sc * 2); char* K_lds = lds + 2 * SHM_V;
    const int kb0 = swa_jlo(cur.P0, cur.W) * KVBLK;
    for (int d0 = 0; d0 < 8; ++d0) S.qr[d0] = load8(cur.Q + (size_t)(wid * QBLK + r32) * LDP + d0 * 16 + hi * 8);
    SLOAD_H(cur.K, cur.V, kb0); VMW(); SWRITE_HK(0);
    __syncthreads();
}
DI void block(const BlockRef& cur, const BlockRef& nxt, int skv, char* lds, Seam& S, int wv) {
    const int tid = tid_(wv), wid = __builtin_amdgcn_readfirstlane(tid >> 6), lane = tid & 63, r32 = lane & 31, hi = lane >> 5;
    const int W = cur.W;
    const int j_lo = swa_jlo(cur.P0, W);
    int j_hi = (cur.P0 + QB - 1) / KVBLK + 1; if (j_hi > skv / KVBLK) j_hi = skv / KVBLK;
    const int NT_ = j_hi - j_lo;
    const int kbn = swa_jlo(nxt.P0, nxt.W) * KVBLK;
    const int qlo = cur.P0 + wid * QBLK, qm = qlo + r32 - 4 * hi;
    char* V_lds = lds; char* K_lds = lds + 2 * SHM_V;
    float* ws = (float*)(lds + 2 * SHM_V + 2 * SHM_K) + wid * 64; float* li_l = ws, * al_l = ws + 32;
    float m_reg = -1e30f, l_reg = 0; f32x16 o[4] = {};
    const int sr = tid >> 4, sc = (tid & 15) * 8, vst0 = v_st(sr, sc), vst1 = v_st(32 + sr, sc), kws = KSWZ(sr, sc * 2);
    const int vb0 = (int)(uintptr_t)V_lds + v_rd_base(lane);
    const bf16_t* Kh = cur.K; const bf16_t* Vh = cur.V;
    unsigned long long selm = ~0ull;
    if (cur.sel) { const u32x2 w = *(const u32x2*)(cur.sel + 2 * (wid * QBLK + r32)); selm = ((unsigned long long)w[1] << 32) | w[0]; }
#define RESC(a) do { if (__any((a) < 1.f)) { if (hi == 0) al_l[r32] = (a); asm volatile("s_waitcnt lgkmcnt(0)" ::: "memory");              \
                     for (int d_ = 0; d_ < 4; ++d_) for (int r = 0; r < 16; ++r) o[d_][r] *= al_l[crow(r, hi)]; } } while (0)
#define KBASE(t) ((j_lo + (t)) * KVBLK)
#define MASKT(P0_, P1_, t) do { const int kb_ = KBASE(t); if (kb_ + KVBLK - 1 > qlo || kb_ <= qlo + QBLK - 1 - W) mask_tile(P0_, P1_, qm - kb_, (unsigned)W); \
        if (cur.sel) { if (!((selm >> (j_lo + (t))) & 1ull)) { const float NEG_ = -__builtin_inff(); for (int r = 0; r < 16; ++r) { P0_[r] = NEG_; P1_[r] = NEG_; } } } } while (0)
    constexpr int NQL = 8;
#define SEAM_K0() do { VMWN(NQL); SWRITE_HK(0); SBAR(); } while (0)
    f32x16 pA0, pA1, pB0, pB1; float mnA, mnB, alA, alB; bf16x8 pa0, pa1, pa2, pa3;
    SWRITE_HV(0); SBAR();
    if (NT_ > 1) { SLOAD_H(Kh, Vh, KBASE(1)); }
    SBAR(); qkt<0>(pA0, pA1, K_lds, r32, hi, S.qr);
    MASKT(pA0, pA1, 0); partialSM(pA0, pA1, m_reg, mnA, alA);
    if (NT_ > 1) { VMW(); SWRITE_H(1); }
    __syncthreads();
#define HALF_STEP(PX0, PX1, mnX, alX, PY0, PY1, alY, t, KB, VB, SB) do {                                                      \
        SBAR(); qkt<KB>(PX0, PX1, K_lds, r32, hi, S.qr);                                             \
        finishSM(PY0, PY1, alY, l_reg, pa0, pa1, pa2, pa3); SBAR();                                                           \
        if ((t) + 1 < NT_) { SLOAD_H(Kh, Vh, KBASE((t) + 1)); SBAR(); }                                               \
        pv_tile<VB>(o, vb0, pa0, pa1, pa2, pa3); MASKT(PX0, PX1, (t)); partialSM(PX0, PX1, m_reg, mnX, alX);                                        \
        __syncthreads();                                                                                                      \
        if ((t) + 1 < NT_) { VMW(); SWRITE_H(SB); }                                                                          \
        RESC(alX); __syncthreads(); } while (0)
    for (int t = 1; t + 1 < NT_; t += 2) {
        HALF_STEP(pB0, pB1, mnB, alB, pA0, pA1, alA, t, 1, 0, 0);
        HALF_STEP(pA0, pA1, mnA, alA, pB0, pB1, alB, t + 1, 0, 1, 1);
    }
    const bool even = (NT_ & 1) == 0;
    if (even) { SBAR(); qkt<1>(pB0, pB1, K_lds, r32, hi, S.qr); SBAR(); }
    SLOAD_H(nxt.K, nxt.V, kbn); SBAR();
#pragma unroll
    for (int d0 = 0; d0 < 8; ++d0) S.qr[d0] = load8(nxt.Q + (size_t)(wid * QBLK + r32) * LDP + d0 * 16 + hi * 8);
    SBAR();
    finishSM(pA0, pA1, alA, l_reg, pa0, pa1, pa2, pa3); SBAR();
    pv_tile<0>(o, vb0, pa0, pa1, pa2, pa3);
    if (even) { MASKT(pB0, pB1, NT_ - 1); partialSM(pB0, pB1, m_reg, mnB, alB); __syncthreads(); RESC(alB);
        finishSM(pB0, pB1, alB, l_reg, pa0, pa1, pa2, pa3); SBAR(); pv_tile<1>(o, vb0, pa0, pa1, pa2, pa3); }
    SBAR(); SEAM_K0();
    { const float gatev = 1.f / (1.f + __expf(-bf2f(cur.gate[(size_t)(wid * QBLK + r32) * LDP]))); if (hi == 0) li_l[r32] = gatev / l_reg; } asm volatile("s_waitcnt lgkmcnt(0)" ::: "memory");
    float rli[16];
#pragma unroll
    for (int r = 0; r < 16; ++r) rli[r] = li_l[crow(r, hi)];
    float* Ow = cur.Of + (size_t)(wid * QBLK) * DM;
    if (cur.mode == 0) {
#pragma unroll
        for (int r = 0; r < 16; ++r) { const int orow = crow(r, hi);
#pragma unroll
            for (int d0 = 0; d0 < 4; ++d0) { float* p = Ow + (size_t)orow * DM + d0 * 32 + r32; *p = *p + o[d0][r] * rli[r]; } }
    } else {
        bf16_t* Obw = cur.Ob + (size_t)(wid * QBLK) * DM;
#pragma unroll
        for (int r = 0; r < 16; ++r) { const int orow = crow(r, hi);
#pragma unroll
            for (int d0 = 0; d0 < 4; ++d0) { const float v = o[d0][r] * rli[r] + Ow[(size_t)orow * DM + d0 * 32 + r32];
                const float vn = swz<1>(v);
                if ((r32 & 1) == 0) *(unsigned*)(Obw + (size_t)orow * DM + d0 * 32 + r32) = pk2(v, vn); } }
    }
    __syncthreads();
#undef RESC
#undef KBASE
#undef MASKT
#undef SEAM_K0
#undef HALF_STEP
}
#undef ROW
#undef VMW
#undef VMWN
#undef SLOAD_H
#undef SWRITE_HK
#undef SWRITE_HV
#undef SWRITE_H
DI BlockRef make_ref(int L, int step, int hf, const bf16_t* PROJ, float* NSAF, bf16_t* NSA, const unsigned* SEL) {
    const int y = L & 7, head = (L >> 3) & 15, bl = L >> 7, g = head >> 3;
    const int qb = (step & 2) ? 15 - y : y, win = step & 1;
    const int P0 = qb * QB;
    const size_t lrow0 = (size_t)bl * SEQ;
    BlockRef r;
    r.Q = PROJ + (lrow0 + P0) * LDP + C_NQ + head * 128;
    r.K = PROJ + lrow0 * LDP + (win ? C_KW : C_KS) + g * 128;
    r.V = PROJ + lrow0 * LDP + (win ? C_VW : C_VS) + g * 128;
    r.Of = NSAF + (lrow0 + P0) * DM + head * 128;
    r.Ob = NSA + (lrow0 + P0) * DM + head * 128;
    r.sel = win ? nullptr : SEL + ((size_t)((hf * 2 + bl) * 2 + g) * SEQ + P0) * 2;
    r.gate = PROJ + (lrow0 + P0) * LDP + C_NG + head * 3 + (win ? 2 : 1);
    r.P0 = P0; r.W = win ? 512 : (1 << 30); r.mode = win;
    return r;
}
DI void phase(int hf, const bf16_t* PROJ, float* NSAF, bf16_t* NSA, const unsigned* SEL, char* lds, int bid, int G, int wv) {
    const int total = 2 * 16 * 8;
    int L = bid; if (L >= total) return;
    int step = 0;
    BlockRef cur = make_ref(L, 0, hf, PROJ, NSAF, NSA, SEL);
    Seam S;
    prime(cur, lds, S, wv);
    for (;;) {
        int Ln = L, stepn = step + 1;
        if (stepn == 4) { stepn = 0; Ln = L + G; }
        const bool last = (stepn == 0 && Ln >= total);
        const BlockRef nxt = last ? cur : make_ref(Ln, stepn, hf, PROJ, NSAF, NSA, SEL);
        block(cur, nxt, SEQ, lds, S, wv);
        if (last) break;
        cur = nxt; L = Ln; step = stepn;
    }
}
}

DI void conv_item(int item, const bf16_t* U, const float* cw, const float* cb, bf16_t* ACT, int wv) {
    U = lnd(U); cw = lnd(cw); cb = lnd(cb); ACT = lnd(ACT); const int tid0 = tid_(wv);
    const int r0 = item * 32; const int tpos0 = r0 & (SEQ - 1);
    for (int cgp = tid0; cgp < DFF / 8; cgp += NT) {
        const int col = cgp * 8;
        float wa[3][8], wb[3][8], ba[8], bb[8];
#pragma unroll
        for (int k = 0; k < 3; ++k) { const f32x4 a0 = *(const f32x4*)(cw + k * DFF2 + col), a1 = *(const f32x4*)(cw + k * DFF2 + col + 4), b0 = *(const f32x4*)(cw + k * DFF2 + DFF + col), b1 = *(const f32x4*)(cw + k * DFF2 + DFF + col + 4);
#pragma unroll
            for (int j = 0; j < 4; ++j) { wa[k][j] = a0[j]; wa[k][4 + j] = a1[j]; wb[k][j] = b0[j]; wb[k][4 + j] = b1[j]; } }
        { const f32x4 a0 = *(const f32x4*)(cb + col), a1 = *(const f32x4*)(cb + col + 4), b0 = *(const f32x4*)(cb + DFF + col), b1 = *(const f32x4*)(cb + DFF + col + 4);
#pragma unroll
          for (int j = 0; j < 4; ++j) { ba[j] = a0[j]; ba[4 + j] = a1[j]; bb[j] = b0[j]; bb[4 + j] = b1[j]; } }
        u32x4 a2 = {0, 0, 0, 0}, a1 = {0, 0, 0, 0}, b2 = {0, 0, 0, 0}, b1 = {0, 0, 0, 0};
        if (tpos0 != 0) { const bf16_t* p = U + (size_t)(r0 - 2) * DFF2 + col; a2 = *(const u32x4*)p; b2 = *(const u32x4*)(p + DFF); a1 = *(const u32x4*)(p + DFF2); b1 = *(const u32x4*)(p + DFF2 + DFF); }
        for (int r = 0; r < 32; ++r) {
            const bf16_t* p = U + (size_t)(r0 + r) * DFF2 + col;
            const u32x4 a0 = *(const u32x4*)p, b0 = *(const u32x4*)(p + DFF);
            float res[8];
#pragma unroll
            for (int j = 0; j < 4; ++j) {
                const float ua0 = wa[0][2 * j] * bflo(a2[j]) + wa[1][2 * j] * bflo(a1[j]) + wa[2][2 * j] * bflo(a0[j]) + ba[2 * j];
                const float ua1 = wa[0][2 * j + 1] * bfhi(a2[j]) + wa[1][2 * j + 1] * bfhi(a1[j]) + wa[2][2 * j + 1] * bfhi(a0[j]) + ba[2 * j + 1];
                const float ub0 = wb[0][2 * j] * bflo(b2[j]) + wb[1][2 * j] * bflo(b1[j]) + wb[2][2 * j] * bflo(b0[j]) + bb[2 * j];
                const float ub1 = wb[0][2 * j + 1] * bfhi(b2[j]) + wb[1][2 * j + 1] * bfhi(b1[j]) + wb[2][2 * j + 1] * bfhi(b0[j]) + bb[2 * j + 1];
                res[2 * j] = siluf_(ua0) * ub0; res[2 * j + 1] = siluf_(ua1) * ub1;
            }
            u32x4 w = {pk2(res[0], res[1]), pk2(res[2], res[3]), pk2(res[4], res[5]), pk2(res[6], res[7])};
            *(u32x4*)(ACT + (size_t)(r0 + r) * DFF + col) = w;
            a2 = a1; a1 = a0; b2 = b1; b1 = b0;
        }
    }
}

struct Args { const float* in[19]; float* out; unsigned char* ws; };

__global__ void __launch_bounds__(NT, 2) fwd_kernel(Args a) {
    extern __shared__ __attribute__((aligned(16))) unsigned char lds_raw[];
    LAS unsigned char* lds = (LAS unsigned char*)lds_raw;
    cg::grid_group grid = cg::this_grid();
    const int G = gridDim.x, bid = blockIdx.x;
    const int wv0 = __builtin_amdgcn_readfirstlane((int)threadIdx.x >> 6);
    const int NGW = G * 8;
    unsigned epoch = 0u;
#define GBAR() grid_bar((unsigned*)a.ws, epoch, G, wv0)
    const float* x = a.in[0];
    float* out = a.out;
#define PHASE_IDS() const int tid = tid_(wv0), lane = tid & 63, wave = __builtin_amdgcn_readfirstlane(tid >> 6), gw = bid * 8 + wave; (void)lane; (void)gw; \
    unsigned char* ws = lnd(a.ws); LAS float* scr = (LAS float*)(lds + wave * 16384); (void)scr; \
    bf16_t* WIN_T = (bf16_t*)(ws + WS_WIN); bf16_t* WRET_T = (bf16_t*)(ws + WS_WRET); bf16_t* WNSA_T = (bf16_t*)(ws + WS_WNSA); bf16_t* WOUT_T = (bf16_t*)(ws + WS_WOUT); \
    bf16_t* XN = (bf16_t*)(ws + WS_XN); bf16_t* ARET = XN; bf16_t* PROJ = (bf16_t*)(ws + WS_PROJ); bf16_t* NSA = (bf16_t*)(ws + WS_NSA); \
    bf16_t* KT = (bf16_t*)(ws + WS_KT); bf16_t* VT = (bf16_t*)(ws + WS_VT); bf16_t* STATE = (bf16_t*)(ws + WS_STATE); bf16_t* MX = (bf16_t*)(ws + WS_MX); \
    float* ROTC = (float*)(ws + WS_ROTC); float* ROTS = (float*)(ws + WS_ROTS); \
    bf16_t* W1K_T = (bf16_t*)(ws + WS_W1K); bf16_t* W1V_T = (bf16_t*)(ws + WS_W1V); bf16_t* W2K_T = (bf16_t*)(ws + WS_W2K); bf16_t* W2V_T = (bf16_t*)(ws + WS_W2V); \
    bf16_t* KCMP = (bf16_t*)(ws + WS_KCMP); bf16_t* VCMPT = (bf16_t*)(ws + WS_VCMPT); unsigned* SEL = (unsigned*)(ws + WS_SEL); \
    (void)W1K_T; (void)W1V_T; (void)W2K_T; (void)W2V_T; (void)KCMP; (void)VCMPT; (void)SEL; \
    bf16_t* WUP_T = (bf16_t*)(ws + WS_WUP); bf16_t* WDOWN_T = (bf16_t*)(ws + WS_WDOWN); bf16_t* XN2 = (bf16_t*)(ws + WS_XN2); bf16_t* U = (bf16_t*)(ws + WS_U); bf16_t* ACT = (bf16_t*)(ws + WS_ACT); \
    (void)WIN_T; (void)WRET_T; (void)WNSA_T; (void)WOUT_T; (void)XN; (void)ARET; (void)PROJ; (void)NSA; (void)KT; (void)VT; (void)STATE; (void)MX; (void)ROTC; (void)ROTS; (void)WUP_T; (void)WDOWN_T; (void)XN2; (void)U; (void)ACT;

#if STAGE >= 2
    { PHASE_IDS();
        constexpr int I_IN = 32 * 440, I_SQ = 32 * 64;
        constexpr int I_W1 = 64 * 8, I_W2 = 4 * 4;
        constexpr int NIT = I_IN + 3 * I_SQ + 2 * I_W1 + 2 * I_W2;
        for (int it = gw; it < NIT; it += NGW) {
            int r = it;
            if (r >= I_IN + 3 * I_SQ) { r -= I_IN + 3 * I_SQ;
                if (r < I_W1) { transpose_item(a.in[6], 4096, 256, W1K_T, scr, r, 8, lane); continue; } r -= I_W1;
                if (r < I_W1) { transpose_item(a.in[9], 4096, 256, W1V_T, scr, r, 8, lane); continue; } r -= I_W1;
                if (r < I_W2) { transpose_item(a.in[7], 256, 128, W2K_T, scr, r, 4, lane); continue; } r -= I_W2;
                transpose_item(a.in[10], 256, 128, W2V_T, scr, r, 4, lane); continue; }
            if (r < I_IN) { transpose_item(a.in[2], DM, NCOL, WIN_T, scr, r, 440, lane); continue; } r -= I_IN;
            if (r < I_SQ) { transpose_item(a.in[4], DM, DM, WRET_T, scr, r, 64, lane); continue; } r -= I_SQ;
            if (r < I_SQ) { transpose_item(a.in[11], DM, DM, WNSA_T, scr, r, 64, lane); continue; } r -= I_SQ;
            transpose_item(a.in[12], DM, DM, WOUT_T, scr, r, 64, lane);
        }
        for (int i = bid * NT + tid; i < SEQ * 64; i += G * NT) {
            const int pos = i >> 6, f = i & 63;
            const float freq = exp2f(-(float)f * (13.287712379549449f / 64.f));
            const float ang = (float)pos * freq;
            ROTC[i] = cosf(ang); ROTS[i] = sinf(ang);
        }
        for (int m = gw; m < MH; m += NGW) rms_row_bf16(x + (size_t)m * DM, a.in[1], XN + (size_t)m * DM, lane);
    }
    grid.sync();
    for (int hf = 0; hf < 2; ++hf) {
        const size_t grow0 = (size_t)hf * MH;
        { PHASE_IDS();
            pg8::Gemm g{XN, WIN_T, MH, LDP, DM}; pg8::StaticOrder S; S.init(MH, LDP, G, bid);
            pg8::Epi<0> E{PROJ, LDP, nullptr, 0, nullptr, 0};
            pg8::gemm_phase(lds, g, S, E, wv0);
        }
        GBAR();
        { PHASE_IDS(); for (int it = bid; it < 16 * 64; it += G) rot_item(it, PROJ, ROTC, ROTS, KT, VT, lds, wv0); }
#if STAGE >= 3
        { PHASE_IDS(); for (int it = G - 1 - bid; it < 128; it += G) cmp_item(it, hf, PROJ, a.in[5], a.in[8], W1K_T, W1V_T, W2K_T, W2V_T, KCMP, VCMPT, lds, wv0); }
#endif
        GBAR();
        { PHASE_IDS(); for (int it = bid; it < 16 * 32; it += G) retA_item(it, KT, VT, STATE, wv0); }
#if STAGE >= 3
        { PHASE_IDS(); for (int it = bid; it < 512; it += G) cattn_item(it, hf, PROJ, KCMP, VCMPT, out + grow0 * DM, SEL, lds, wv0); }
#endif
        GBAR();
        { PHASE_IDS(); for (int i = bid * NT + tid; i < 131072; i += G * NT) retB_scan(STATE, i, wv0); }
#if STAGE >= 3
        { PHASE_IDS(); att::phase(hf, PROJ, out + grow0 * DM, NSA, SEL, (char*)lds_raw, bid, G, wv0); }
#endif
        GBAR();
        { PHASE_IDS(); for (int it = bid; it < 16 * 32; it += G) retC_item(it, PROJ, VT, STATE, a.in[3], ARET, lds, wv0); }
        GBAR();
        { PHASE_IDS();
            pg8::Gemm g{ARET, WRET_T, MH, DM, DM}; pg8::StaticOrder S; S.init(MH, DM, G, bid);
            pg8::Epi<1> E{out + grow0 * DM, DM, PROJ + C_MG, LDP, nullptr, 0};
            pg8::gemm_phase(lds, g, S, E, wv0);
        }
#if STAGE >= 3
        { PHASE_IDS();
            pg8::Gemm g{NSA, WNSA_T, MH, DM, DM}; pg8::StaticOrder S; S.init(MH, DM, G, bid);
            pg8::Epi<2> E{MX, DM, PROJ + C_MG + DM, LDP, out + grow0 * DM, DM};
            pg8::gemm_phase(lds, g, S, E, wv0);
        }
#else
        GBAR();
        { PHASE_IDS(); for (size_t i = (size_t)bid * NT + tid; i < (size_t)MH * DM / 4; i += (size_t)G * NT) {
            const f32x4 v = *((const f32x4*)(out + grow0 * DM) + i); u32x2 o = {pk2(v.x, v.y), pk2(v.z, v.w)}; *((u32x2*)MX + i) = o; } }
#endif
        GBAR();
        { PHASE_IDS();
            pg8::Gemm g{MX, WOUT_T, MH, DM, DM}; pg8::StaticOrder S; S.init(MH, DM, G, bid);
            pg8::Epi<3> E{out + grow0 * DM, DM, x + grow0 * DM, DM, nullptr, 0};
            pg8::gemm_phase(lds, g, S, E, wv0);
        }
        if (hf == 0) { PHASE_IDS(); for (int m = gw; m < MH; m += NGW) rms_row_bf16(x + (size_t)(MH + m) * DM, a.in[1], XN + (size_t)m * DM, lane); }
        GBAR();
    }
#else
    { PHASE_IDS(); for (size_t i = (size_t)bid * NT + tid; i < (size_t)MTOK * DM / 4; i += (size_t)G * NT) ((f32x4*)out)[i] = ((const f32x4*)x)[i]; }
    GBAR();
#endif
    { PHASE_IDS();
        constexpr int I_UP = 32 * 352, I_DN = 88 * 64;
        for (int it = gw; it < I_UP + I_DN; it += NGW) {
            if (it < I_UP) transpose_item(a.in[14], DM, DFF2, WUP_T, scr, it, 352, lane);
            else transpose_item(a.in[17], DFF, DM, WDOWN_T, scr, it - I_UP, 64, lane);
        }
        for (int m = gw; m < MTOK; m += NGW) rms_row_bf16(out + (size_t)m * DM, a.in[13], XN2 + (size_t)m * DM, lane);
    }
    GBAR();
    for (int hf = 0; hf < 2; ++hf) {
        const size_t grow0 = (size_t)hf * MH;
        { PHASE_IDS();
            pg8::Gemm g{XN2 + grow0 * DM, WUP_T, MH, DFF2, DM}; pg8::StaticOrder S; S.init(MH, DFF2, G, bid);
            pg8::Epi<0> E{U, DFF2, nullptr, 0, nullptr, 0};
            pg8::gemm_phase(lds, g, S, E, wv0);
        }
        GBAR();
        { PHASE_IDS(); for (int it = bid; it < MH / 32; it += G) conv_item(it, U, a.in[15], a.in[16], ACT, wv0); }
        GBAR();
        { PHASE_IDS();
            pg8::Gemm g{ACT, WDOWN_T, MH, DM, DFF}; pg8::StaticOrder S; S.init(MH, DM, G, bid);
            pg8::Epi<4> E{out + grow0 * DM, DM, nullptr, 0, nullptr, 0};
            pg8::gemm_phase(lds, g, S, E, wv0);
        }
        GBAR();
    }
    { PHASE_IDS(); for (int m = gw; m < MTOK; m += NGW) rms_row_f32(out + (size_t)m * DM, a.in[18], lane); }
}

extern "C" void kernel_launch(void* const* d_in, const int* in_sizes, int n_in, void* d_out, int out_size, void* d_ws, size_t ws_size, hipStream_t stream) {
    static int grid = 0;
    if (grid == 0) {
        if (n_in != 19 || out_size != MTOK * DM || ws_size < WS_END) { fprintf(stderr, "kernel_launch: unexpected shapes (n_in %d out %d ws %zu)\n", n_in, out_size, ws_size); grid = -1; return; }
        int dev = 0, cus = 0, per_cu = 0;
        (void)hipGetDevice(&dev); (void)hipDeviceGetAttribute(&cus, hipDeviceAttributeMultiprocessorCount, dev);
        if (hipFuncSetAttribute((const void*)fwd_kernel, hipFuncAttributeMaxDynamicSharedMemorySize, LDS_BYTES) != hipSuccess) { fprintf(stderr, "hipFuncSetAttribute failed\n"); grid = -1; return; }
        if (hipOccupancyMaxActiveBlocksPerMultiprocessor(&per_cu, (const void*)fwd_kernel, NT, LDS_BYTES) != hipSuccess || per_cu < 1) { fprintf(stderr, "occupancy query: %d\n", per_cu); per_cu = 1; }
        (void)hipGetLastError();
        grid = cus > 0 ? cus : 256;
    }
    if (grid < 0) return;
    Args a{};
    for (int i = 0; i < 19; ++i) a.in[i] = (const float*)d_in[i];
    a.out = (float*)d_out; a.ws = (unsigned char*)d_ws;
    (void)hipMemsetAsync(d_ws, 0, 256, stream);
    void* args[] = {&a};
    hipError_t e = hipLaunchCooperativeKernel((const void*)fwd_kernel, dim3(grid), dim3(NT), args, LDS_BYTES, stream);
    if (e != hipSuccess) fprintf(stderr, "cooperative launch failed: %s (grid %d)\n", hipGetErrorString(e), grid);
}
```

```cpp
#include <hip/hip_runtime.h>
#include <hip/hip_cooperative_groups.h>
#include <cstdio>
#include <cstdint>
namespace cg = cooperative_groups;

#ifndef STAGE
#define STAGE 3
#endif

#define LAS __attribute__((address_space(3)))
typedef unsigned short bf16_t;
typedef short bf16x8 __attribute__((ext_vector_type(8)));
typedef short s16x4 __attribute__((ext_vector_type(4)));
typedef float f32x4 __attribute__((ext_vector_type(4)));
typedef float f32x16 __attribute__((ext_vector_type(16)));
typedef unsigned u32x4 __attribute__((ext_vector_type(4)));
typedef unsigned u32x2 __attribute__((ext_vector_type(2)));
typedef __bf16 bf16v2 __attribute__((ext_vector_type(2)));
typedef float f32v2 __attribute__((ext_vector_type(2)));
#define DI __device__ __forceinline__
#define LDS_WAIT() asm volatile("s_waitcnt lgkmcnt(0)" ::: "memory")
#define MFMA32(a, b, c) __builtin_amdgcn_mfma_f32_32x32x16_bf16((a), (b), (c), 0, 0, 0)
#define MFMA16(a, b, c) __builtin_amdgcn_mfma_f32_16x16x32_bf16((a), (b), (c), 0, 0, 0)

constexpr int DM = 2048, SEQ = 4096, MTOK = 16384, MH = 8192;
constexpr int NCOL = 13872, LDP = 14080;
constexpr int C_RQ = 0, C_RK = 1024, C_RV = 2048, C_RG = 4096, C_NQ = 6144, C_KC = 8192, C_VC = 8448, C_KS = 8704, C_VS = 8960,
              C_KW = 9216, C_VW = 9472, C_NG = 9728, C_MG = 9776;
constexpr int DFF = 5632, DFF2 = 11264;
constexpr float EPS = 1e-6f;
constexpr size_t MiB = 1u << 20;
constexpr size_t WS_WIN = 1 * MiB, WS_WRET = 56 * MiB, WS_WNSA = 64 * MiB, WS_WOUT = 72 * MiB, WS_W1K = 80 * MiB, WS_W1V = 82 * MiB,
                 WS_W2K = 84 * MiB, WS_W2V = 84 * MiB + 65536, WS_ROTC = 85 * MiB, WS_ROTS = 86 * MiB, WS_KCMP = 87 * MiB, WS_VCMPT = 87 * MiB + 524288,
                 WS_SEL = 88 * MiB, WS_XN = 90 * MiB  , WS_PROJ = 122 * MiB, WS_NSA = 342 * MiB, WS_KT = 374 * MiB, WS_VT = 390 * MiB,
                 WS_STATE = 422 * MiB, WS_MX = 374 * MiB  ,
                 WS_WUP = 90 * MiB, WS_WDOWN = 134 * MiB, WS_XN2 = 156 * MiB, WS_U = 220 * MiB, WS_ACT = 220 * MiB, WS_UB = 396 * MiB, WS_PB = 420 * MiB, WS_KP = 454 * MiB, WS_VP = 456 * MiB, WS_END = 484 * MiB;
constexpr int LDS_BYTES = 143360;
constexpr int NT = 512;

DI unsigned pk2(float lo, float hi) { f32v2 v = {lo, hi}; bf16v2 b = __builtin_convertvector(v, bf16v2); return __builtin_bit_cast(unsigned, b); }
DI float bf2f(unsigned short b) { return __uint_as_float(((unsigned)b) << 16); }
DI float bflo(unsigned w) { return __uint_as_float(w << 16); }
DI float bfhi(unsigned w) { return __uint_as_float(w & 0xffff0000u); }
DI bf16x8 pack8(f32x4 a, f32x4 b) { u32x4 w = {pk2(a[0], a[1]), pk2(a[2], a[3]), pk2(b[0], b[1]), pk2(b[2], b[3])}; return __builtin_bit_cast(bf16x8, w); }
DI float sigmoidf_(float x) { return __builtin_amdgcn_rcpf(1.f + __builtin_amdgcn_exp2f(-1.4426950408889634f * x)); }
DI float siluf_(float x) { return x * __builtin_amdgcn_rcpf(1.f + __builtin_amdgcn_exp2f(-1.4426950408889634f * x)); }
template <int M> DI float swz(float v) { return __int_as_float(__builtin_amdgcn_ds_swizzle(__float_as_int(v), (M << 10) | 0x1F)); }
template <int M> DI unsigned swzu(unsigned v) { return (unsigned)__builtin_amdgcn_ds_swizzle((int)v, (M << 10) | 0x1F); }
DI float xor32(float v, int hi) { auto rr = __builtin_amdgcn_permlane32_swap(__float_as_uint(v), __float_as_uint(v), false, false); return __uint_as_float(hi ? rr[0] : rr[1]); }
DI float sum32(float v) { auto rr = __builtin_amdgcn_permlane32_swap(__float_as_uint(v), __float_as_uint(v), false, false); return __uint_as_float(rr[0]) + __uint_as_float(rr[1]); }
DI float wave_sum(float v) { v += swz<1>(v); v += swz<2>(v); v += swz<4>(v); v += swz<8>(v); v += swz<16>(v); return sum32(v); }
DI int tid_(int wv) { int t; asm volatile("v_mbcnt_lo_u32_b32 %0, -1, 0\n\tv_mbcnt_hi_u32_b32 %0, -1, %0" : "=v"(t)); return (wv << 6) | t; }
#define XB_TMO      128
#define XB_XCNT(j)  (256  + 64 * (j))
#define XB_XSUB(j)  (1280 + 64 * (j))
#define XB_XGEN(j)  (2304 + 64 * (j))
#define XB_TOP      3328
#define XB_TOPGEN   3392
#define XCD_BAR_WORDS 3456
#define XB_SPIN_CAP (1u << 20)
DI unsigned xb_ld(unsigned* p)              { return __hip_atomic_load(p, __ATOMIC_RELAXED, __HIP_MEMORY_SCOPE_AGENT); }
DI unsigned xb_add(unsigned* p, unsigned v) { return __hip_atomic_fetch_add(p, v, __ATOMIC_RELAXED, __HIP_MEMORY_SCOPE_AGENT); }
DI unsigned xb_xcc_id() { return (unsigned)__builtin_amdgcn_s_getreg((3 << 11) | 20) & 0xFu; }
#define XB_SPIN(cond, bar) do { unsigned _sp = 0; while (cond) { __builtin_amdgcn_s_sleep(1); \
    if ((++_sp & 255u) == 0u) { if (xb_ld(&(bar)[XB_TMO])) break; if (_sp > XB_SPIN_CAP) { atomicAdd(&(bar)[XB_TMO], 1u); break; } } } } while (0)
DI void xcd_barrier_complete(unsigned* bar, unsigned x, unsigned G, unsigned& nloc, unsigned& nx) {
    unsigned sum, cnt, mine, sp = 0u;
    for (;;) {
        sum = 0u; cnt = 0u; mine = 0u;
#pragma unroll
        for (unsigned j = 0; j < 16; ++j) { const unsigned c = xb_ld(&bar[XB_XCNT(j)]); sum += c; cnt += (c > 0u) ? 1u : 0u; mine = (j == x) ? c : mine; }
        if (sum == G) break;
        __builtin_amdgcn_s_sleep(1);
        if ((++sp & 255u) == 0u) { if (xb_ld(&bar[XB_TMO])) break; if (sp > XB_SPIN_CAP) { atomicAdd(&bar[XB_TMO], 1u); break; } }
    }
    nloc = mine > 0u ? mine : 1u; nx = cnt > 0u ? cnt : 1u;
}
DI void grid_bar(unsigned* bar, volatile LAS unsigned* st, unsigned x, int G, int wv) {
    asm volatile("s_waitcnt vmcnt(0)" ::: "memory");
    __syncthreads();
    const int t = tid_(wv);
    if (t == 0) {
        __builtin_amdgcn_s_waitcnt(0);
        unsigned nloc = st[0], nx = st[1];
        if (nloc == 0u) { xcd_barrier_complete(bar, x, (unsigned)G, nloc, nx); st[0] = nloc; st[1] = nx; }
        const unsigned old = xb_add(&bar[XB_XSUB(x)], 1u);
        const unsigned gen = old / nloc;
        if (old + 1u == (gen + 1u) * nloc) {
            __builtin_amdgcn_fence(__ATOMIC_RELEASE, "agent");
            asm volatile("s_waitcnt vmcnt(0)" ::: "memory");
            const unsigned og = xb_add(&bar[XB_TOP], 1u);
            const unsigned tg = og / nx;
            if (og + 1u == (tg + 1u) * nx) xb_add(&bar[XB_TOPGEN], 1u);
            else XB_SPIN(xb_ld(&bar[XB_TOPGEN]) == tg, bar);
            __builtin_amdgcn_fence(__ATOMIC_ACQUIRE, "agent");
            xb_add(&bar[XB_XGEN(x)], 1u);
            asm volatile("s_waitcnt vmcnt(0)" ::: "memory");
        } else {
            XB_SPIN(xb_ld(&bar[XB_XGEN(x)]) == gen, bar);
            __builtin_amdgcn_fence(__ATOMIC_ACQUIRE, "agent");
            asm volatile("s_waitcnt vmcnt(0)" ::: "memory");
        }
    }
    __syncthreads();
}
DI int zero_() { int z = 0; asm volatile("" : "+s"(z)); return z; }
template <class T> DI T* lnd(T* p) { return p + zero_(); }
DI int crow(int r, int hi) { return (r & 3) + 8 * (r >> 2) + 4 * hi; }
DI float log2gamma(int h) { return log2f(1.0f - exp2f(-5.0f - (float)h)); }

namespace pg8 {
constexpr int BM = 256, BK = 64, HALF = 128, HTB = HALF * BK * 2, STAGE_BYTES = 8 * HTB, NXCD = 8, WGM = 8;
DI int lds_byte(int r, int c) { const int st = (r >> 4) * 2 + (c >> 5), rr = r & 15, cc = c & 31, ob = rr * 64 + cc * 2; return st * 1024 + (ob ^ (((ob >> 9) & 1) << 5)); }
DI void stage_rc(int b, int& R, int& C) { const int st = b / 1024, sb = b % 1024, swz = sb ^ (((sb >> 9) & 1) << 5); R = (st >> 1) * 16 + swz / 64; C = (st & 1) * 32 + (swz % 64) / 2; }
DI int perm32(int rho) { const int n = rho >> 4, i = rho & 15; return 8 * (i >> 2) + 4 * n + (i & 3); }
struct Unit { int pm, pn; };
struct Gemm { const bf16_t* A; const bf16_t* Bt; int M, N, K; const bf16_t* A2; const bf16_t* Bt2; };
struct StaticOrder {
    int nM, nN, nwg, G, c;
    DI void init(int M, int N, int G_, int c_) { nM = M / BM; nN = N / BM; nwg = nM * nN; G = G_; c = c_; }
    DI bool next(int i, Unit& u) const {
        const long L = (long)i * G + c; if (L >= nwg) return false;
        int wgid = (int)L; { const int q = nwg / NXCD, r = nwg % NXCD, xcd = wgid % NXCD, off = wgid / NXCD; wgid = (xcd < r ? xcd * (q + 1) : r * (q + 1) + (xcd - r) * q) + off; }
        const int nig = WGM * nN, gid = wgid / nig, fm = gid * WGM, gsz = (nM - fm) < WGM ? (nM - fm) : WGM;
        u.pm = fm + ((wgid % nig) % gsz); u.pn = (wgid % nig) / gsz; return true;
    }
};
template <int MODE> struct Epi {
    void* out; int ldo; const void* aux; int ldaux; const void* aux2; int ldaux2; float* ex1; float* ex2;
    static DI float ror1(float v) { return __int_as_float(__builtin_amdgcn_update_dpp(0, __float_as_int(v), 0x121, 0xf, 0xf, false)); }
    static DI float ror2(float v) { return __int_as_float(__builtin_amdgcn_update_dpp(0, __float_as_int(v), 0x122, 0xf, 0xf, false)); }
    DI void conv_epi(const f32x4 (&acc)[2][2][4][2], const Unit& u, int wr, int wc, int fr, int fq) const {
        const float* cw = (const float*)aux; const float* cb = (const float*)aux2;
        const bool l15 = fr == 15, l14 = fr >= 14;
#pragma unroll
        for (int n = 0; n < 2; ++n) {
            const int col = u.pn * 128 + wc * 32 + 8 * fq + 4 * n;
            const f32x4 wa0 = *(const f32x4*)(cw + col), wa1 = *(const f32x4*)(cw + DFF2 + col), wa2 = *(const f32x4*)(cw + 2 * DFF2 + col), ba = *(const f32x4*)(cb + col);
            const f32x4 wb0 = *(const f32x4*)(cw + DFF + col), wb1 = *(const f32x4*)(cw + DFF2 + DFF + col), wb2 = *(const f32x4*)(cw + 2 * DFF2 + DFF + col), bb = *(const f32x4*)(cb + DFF + col);
#pragma unroll
            for (int ai = 0; ai < 2; ++ai) {
                const int strip = u.pm * 4 + ai * 2 + wr;
                f32x4 ca[4], cbv[4];
#pragma unroll
                for (int m = 0; m < 4; ++m) {
                    const f32x4 va = acc[ai][0][m][n], vb = acc[ai][1][m][n];
                    f32x4 pa1, pa2, pb1, pb2;
#pragma unroll
                    for (int j = 0; j < 4; ++j) {
                        const float am1 = m > 0 ? acc[ai][0][m > 0 ? m - 1 : 0][n][j] : 0.f, bm1 = m > 0 ? acc[ai][1][m > 0 ? m - 1 : 0][n][j] : 0.f;
                        pa1[j] = ror1(l15 ? am1 : va[j]); pa2[j] = ror2(l14 ? am1 : va[j]);
                        pb1[j] = ror1(l15 ? bm1 : vb[j]); pb2[j] = ror2(l14 ? bm1 : vb[j]);
                    }
                    ca[m] = wa0 * pa2 + wa1 * pa1 + wa2 * va + ba;
                    cbv[m] = wb0 * pb2 + wb1 * pb1 + wb2 * vb + bb;
                }
#pragma unroll
                for (int m = 0; m < 4; ++m) {
                    const size_t row = (size_t)(u.pm * BM + ai * HALF + wr * 64 + m * 16 + fr);
                    if (m == 0 && fr < 2) {
                        float* p = ex2 + (size_t)(strip * 2 + fr) * DFF2 + col; *(f32x4*)p = ca[0]; *(f32x4*)(p + DFF) = cbv[0];
                    } else {
                        const f32x4 a = ca[m], b = cbv[m];
                        u32x2 w = {pk2(siluf_(a[0]) * b[0], siluf_(a[1]) * b[1]), pk2(siluf_(a[2]) * b[2], siluf_(a[3]) * b[3])};
                        *(u32x2*)((bf16_t*)out + row * ldo + col) = w;
                    }
                }
                if (fr >= 14) { float* p = ex1 + (size_t)(strip * 2 + (fr - 14)) * DFF2 + col; *(f32x4*)p = acc[ai][0][3][n]; *(f32x4*)(p + DFF) = acc[ai][1][3][n]; }
            }
        }
    }
    DI void scale(f32x4 (&acc)[2][2][4][2], const Unit& u, int wr, int wc, int fr, int fq, int part) const {
        const float keep = part == 0 ? 1.f : 0.f;
#pragma unroll
        for (int ai = 0; ai < 2; ++ai)
#pragma unroll
            for (int m = 0; m < 4; ++m) {
                int rowi = u.pm * BM + wr * 64 + fr + ai * HALF + m * 16; asm volatile("" : "+v"(rowi));
                const bf16_t* gp0 = (const bf16_t*)aux + (size_t)rowi * ldaux + u.pn * BM + wc * 32 + 8 * fq;
#pragma unroll
                for (int bj = 0; bj < 2; ++bj) {
                    const u32x4 gr = *(const u32x4*)(gp0 + bj * HALF), gn = *(const u32x4*)(gp0 + bj * HALF + 2048);
#pragma unroll
                    for (int q = 0; q < 4; ++q) {
                        const float r0 = keep * sigmoidf_(bflo(gr[q])) * (1.f + __builtin_amdgcn_exp2f(fminf(-1.4426950408889634f * bflo(gn[q]), 60.f)));
                        const float r1 = keep * sigmoidf_(bfhi(gr[q])) * (1.f + __builtin_amdgcn_exp2f(fminf(-1.4426950408889634f * bfhi(gn[q]), 60.f)));
                        acc[ai][bj][m][q >> 1][(q & 1) * 2] *= r0; acc[ai][bj][m][q >> 1][(q & 1) * 2 + 1] *= r1;
                    }
                }
                asm volatile("" ::: "memory");
            }
    }
    DI void fin6(const f32x4 (&acc)[2][2][4][2], const Unit& u, int wr, int wc, int fr, int fq) const {
#pragma unroll
        for (int ai = 0; ai < 2; ++ai)
#pragma unroll
            for (int m = 0; m < 4; ++m) {
                int rowi = u.pm * BM + wr * 64 + fr + ai * HALF + m * 16; asm volatile("" : "+v"(rowi));
                const int colb = u.pn * BM + wc * 32 + 8 * fq;
                const bf16_t* gp0 = (const bf16_t*)aux + (size_t)rowi * ldaux + colb + 2048;
#pragma unroll
                for (int bj = 0; bj < 2; ++bj) {
                    const u32x4 g = *(const u32x4*)(gp0 + bj * HALF);
                    const f32x4 v0 = acc[ai][bj][m][0], v1 = acc[ai][bj][m][1];
                    u32x4 w = {pk2(v0[0] * sigmoidf_(bflo(g[0])), v0[1] * sigmoidf_(bfhi(g[0]))), pk2(v0[2] * sigmoidf_(bflo(g[1])), v0[3] * sigmoidf_(bfhi(g[1]))),
                               pk2(v1[0] * sigmoidf_(bflo(g[2])), v1[1] * sigmoidf_(bfhi(g[2]))), pk2(v1[2] * sigmoidf_(bflo(g[3])), v1[3] * sigmoidf_(bfhi(g[3])))};
                    *(u32x4*)((bf16_t*)out + (size_t)rowi * ldo + colb + bj * HALF) = w;
                }
                asm volatile("" ::: "memory");
            }
    }
    DI void operator()(const f32x4 (&acc)[2][2][4][2], const Unit& u, int wr, int wc, int fr, int fq) const {
        if constexpr (MODE == 5) { conv_epi(acc, u, wr, wc, fr, fq); return; }
        if constexpr (MODE == 6) { fin6(acc, u, wr, wc, fr, fq); return; }
        const int row0 = u.pm * BM + wr * 64 + fr, col0 = u.pn * BM + wc * 32 + 8 * fq;
#pragma unroll
        for (int ai = 0; ai < 2; ++ai)
#pragma unroll
            for (int m = 0; m < 4; ++m) {
                const size_t row = (size_t)(row0 + ai * HALF + m * 16);
#pragma unroll
                for (int bj = 0; bj < 2; ++bj) {
                    const int col = col0 + bj * HALF;
                    f32x4 v0 = acc[ai][bj][m][0], v1 = acc[ai][bj][m][1];
                    if constexpr (MODE == 0) {
                        u32x4 w = {pk2(v0[0], v0[1]), pk2(v0[2], v0[3]), pk2(v1[0], v1[1]), pk2(v1[2], v1[3])};
                        *(u32x4*)((bf16_t*)out + row * ldo + col) = w;
                    } else if constexpr (MODE == 1 || MODE == 2) {
                        const u32x4 g = *(const u32x4*)((const bf16_t*)aux + row * ldaux + col);
                        f32x4 g0 = {sigmoidf_(bflo(g[0])), sigmoidf_(bfhi(g[0])), sigmoidf_(bflo(g[1])), sigmoidf_(bfhi(g[1]))};
                        f32x4 g1 = {sigmoidf_(bflo(g[2])), sigmoidf_(bfhi(g[2])), sigmoidf_(bflo(g[3])), sigmoidf_(bfhi(g[3]))};
                        v0 = v0 * g0; v1 = v1 * g1;
                        if constexpr (MODE == 1) { float* o = (float*)out + row * ldo + col; *(f32x4*)o = v0; *(f32x4*)(o + 4) = v1; }
                        else { const float* t = (const float*)aux2 + row * ldaux2 + col; v0 = v0 + *(const f32x4*)t; v1 = v1 + *(const f32x4*)(t + 4);
                            u32x4 w = {pk2(v0[0], v0[1]), pk2(v0[2], v0[3]), pk2(v1[0], v1[1]), pk2(v1[2], v1[3])};
                            *(u32x4*)((bf16_t*)out + row * ldo + col) = w; }
                    } else if constexpr (MODE == 3) {
                        const float* x = (const float*)aux + row * ldaux + col; float* o = (float*)out + row * ldo + col;
                        *(f32x4*)o = v0 + *(const f32x4*)x; *(f32x4*)(o + 4) = v1 + *(const f32x4*)(x + 4);
                    } else {
                        float* o = (float*)out + row * ldo + col;
                        *(f32x4*)o = v0 + *(const f32x4*)o; *(f32x4*)(o + 4) = v1 + *(const f32x4*)(o + 4);
                    }
                }
            }
    }
};

template <class EpiT, bool DUAL = false>
DI void gemm_phase(LAS unsigned char* lds, const Gemm g, const StaticOrder& S, const EpiT& E, int wv) {
    const int tid = tid_(wv), wid = __builtin_amdgcn_readfirstlane(tid >> 6), lane = tid & 63, wr = wid >> 2, wc = wid & 3, fr = lane & 15, fq = lane >> 4;
    int K = g.K; const char* gA = (const char*)g.A; const char* gB = (const char*)g.Bt;
    const char* gA2 = DUAL ? (const char*)g.A2 : gA; const char* gB2 = DUAL ? (const char*)g.Bt2 : gB;
    asm volatile("" : "+s"(K), "+s"(gA), "+s"(gB), "+s"(gA2), "+s"(gB2));
    const int nt = K / BK;
    unsigned voffA[2], voffB[2];
#pragma unroll
    for (int i = 0; i < 2; ++i) { int R, C; stage_rc(tid * 16 + i * 8192, R, C); const int Rb = (R & ~31) + perm32(R & 31);
        voffA[i] = (unsigned)(R * K + C) * 2u; voffB[i] = (unsigned)(Rb * K + C) * 2u; }
    const size_t kstep = (size_t)(BK * 2);
    const size_t hstep = (size_t)HALF * K * 2;
    const size_t tstep = 2 * hstep;
    const unsigned ldsw = (unsigned)wid * 1024u;
    const int aoff = lds_byte(wr * 64 + fr, fq * 8), boff = lds_byte(wc * 32 + fr, fq * 8);
#define PG8_SA(b, h) (((b) * 2 + (h)) * HTB)
#define PG8_SB(b, h) ((4 + (b) * 2 + (h)) * HTB)
#define PG8_STAGE(bufoff, gbase, voff) do { _Pragma("unroll") for (int _i = 0; _i < 2; ++_i) \
        __builtin_amdgcn_global_load_lds((const unsigned*)((const char*)(gbase) + (voff)[_i]), (LAS unsigned*)(lds + (bufoff) + ldsw + _i * 8192), 16, 0, 0); } while (0)
#define PG8_LDA(dst, b, h) do { _Pragma("unroll") for (int m = 0; m < 4; ++m) _Pragma("unroll") for (int k = 0; k < 2; ++k) dst[m][k] = *(const LAS bf16x8*)(lds + PG8_SA(b, h) + aoff + m * 2048 + k * 1024); } while (0)
#define PG8_LDB(dst, b, h) do { _Pragma("unroll") for (int n = 0; n < 2; ++n) _Pragma("unroll") for (int k = 0; k < 2; ++k) dst[n][k] = *(const LAS bf16x8*)(lds + PG8_SB(b, h) + boff + n * 2048 + k * 1024); } while (0)
#define PG8_MMA(ai, bj, At, Bt) do { __builtin_amdgcn_s_setprio(1); _Pragma("unroll") for (int m = 0; m < 4; ++m) _Pragma("unroll") for (int n = 0; n < 2; ++n) _Pragma("unroll") for (int k = 0; k < 2; ++k) \
        acc[ai][bj][m][n] = __builtin_amdgcn_mfma_f32_16x16x32_bf16(Bt[n][k], At[m][k], acc[ai][bj][m][n], 0, 0, 0); __builtin_amdgcn_s_setprio(0); } while (0)
#define PG8_WAIT_V(n) asm volatile("s_waitcnt vmcnt(" #n ")" ::: "memory")
#define PG8_WAIT_L(n) asm volatile("s_waitcnt lgkmcnt(" #n ")" ::: "memory")
#define PG8_BAR __builtin_amdgcn_s_barrier()
#define PG8_SCHED __builtin_amdgcn_sched_barrier(0)
    Unit cur, nxt; int ui = 0; int part = 0; (void)part;
    if (!S.next(0, cur)) return;
    f32x4 acc[2][2][4][2];
#pragma unroll
    for (int a = 0; a < 2; ++a)
#pragma unroll
        for (int b = 0; b < 2; ++b)
#pragma unroll
            for (int m = 0; m < 4; ++m)
#pragma unroll
                for (int n = 0; n < 2; ++n) acc[a][b][m][n] = (f32x4){0.f, 0.f, 0.f, 0.f};
    bf16x8 At[4][2], B0[2][2], B1[2][2];
    const char* cA = gA + (size_t)cur.pm * tstep; const char* cB = gB + (size_t)cur.pn * tstep;
    PG8_STAGE(PG8_SB(0, 0), cB, voffB); PG8_STAGE(PG8_SA(0, 0), cA, voffA); PG8_STAGE(PG8_SB(0, 1), cB + hstep, voffB); PG8_STAGE(PG8_SA(0, 1), cA + hstep, voffA);
    if (wr == 1) PG8_BAR;
    PG8_WAIT_V(4); PG8_BAR;
    PG8_STAGE(PG8_SB(1, 0), cB + kstep, voffB); PG8_STAGE(PG8_SA(1, 0), cA + kstep, voffA); PG8_STAGE(PG8_SB(1, 1), cB + hstep + kstep, voffB);
    PG8_WAIT_V(6); PG8_BAR;
    for (;;) {
        bool has_next; int npart = 0;
        if (DUAL && part == 0) { nxt = cur; npart = 1; has_next = true; }
        else has_next = S.next(ui + 1, nxt);
        const char* nA = has_next ? (npart ? gA2 : gA) + (size_t)nxt.pm * tstep : cA; const char* nB = has_next ? (npart ? gB2 : gB) + (size_t)nxt.pn * tstep : cB;
        for (int t = 0; t < nt; t += 2) {
            const bool last = (t == nt - 2);
            const char* a1 = cA + (size_t)(t + 1) * kstep;
            const char* a2 = last ? nA : cA + (size_t)(t + 2) * kstep; const char* b2 = last ? nB : cB + (size_t)(t + 2) * kstep;
            const char* a3 = a2 + kstep; const char* b3 = b2 + kstep;
            PG8_LDB(B0, 0, 0); PG8_SCHED; PG8_LDA(At, 0, 0); PG8_STAGE(PG8_SA(1, 1), a1 + hstep, voffA);
            PG8_WAIT_L(8); PG8_BAR; PG8_WAIT_L(0); PG8_MMA(0, 0, At, B0); PG8_BAR; PG8_SCHED;
            PG8_LDB(B1, 0, 1); PG8_STAGE(PG8_SB(0, 0), b2, voffB);
            PG8_BAR; PG8_WAIT_L(0); PG8_MMA(0, 1, At, B1); PG8_BAR;
            PG8_LDA(At, 0, 1); PG8_STAGE(PG8_SA(0, 0), a2, voffA);
            PG8_BAR; PG8_WAIT_L(0); PG8_MMA(1, 0, At, B0); PG8_BAR; PG8_SCHED;
            PG8_STAGE(PG8_SB(0, 1), b2 + hstep, voffB);
            PG8_WAIT_V(6); PG8_BAR; PG8_MMA(1, 1, At, B1); PG8_BAR;
            PG8_LDB(B0, 1, 0); PG8_SCHED; PG8_LDA(At, 1, 0); PG8_STAGE(PG8_SA(0, 1), a2 + hstep, voffA);
            PG8_WAIT_L(8); PG8_BAR; PG8_WAIT_L(0); PG8_MMA(0, 0, At, B0); PG8_BAR; PG8_SCHED;
            PG8_LDB(B1, 1, 1); PG8_STAGE(PG8_SB(1, 0), b3, voffB);
            PG8_BAR; PG8_WAIT_L(0); PG8_MMA(0, 1, At, B1); PG8_BAR;
            PG8_LDA(At, 1, 1); PG8_STAGE(PG8_SA(1, 0), a3, voffA);
            PG8_BAR; PG8_WAIT_L(0); PG8_MMA(1, 0, At, B0); PG8_BAR; PG8_SCHED;
            PG8_STAGE(PG8_SB(1, 1), b3 + hstep, voffB);
            PG8_WAIT_V(6); PG8_BAR; PG8_MMA(1, 1, At, B1); PG8_BAR;
        }
        if constexpr (DUAL) {
            if (part == 1) { E(acc, cur, wr, wc, fr, fq); if (!has_next) break; ++ui; }
            E.scale(acc, cur, wr, wc, fr, fq, part);
            part = npart;
        } else {
            E(acc, cur, wr, wc, fr, fq);
            if (!has_next) break;
#pragma unroll
            for (int a = 0; a < 2; ++a)
#pragma unroll
                for (int b = 0; b < 2; ++b)
#pragma unroll
                    for (int m = 0; m < 4; ++m)
#pragma unroll
                        for (int n = 0; n < 2; ++n) acc[a][b][m][n] = (f32x4){0.f, 0.f, 0.f, 0.f};
            ++ui;
        }
        cur = nxt; cA = nA; cB = nB;
    }
    PG8_WAIT_V(0);
    if (wr == 0) PG8_BAR;
    PG8_BAR;
#undef PG8_SA
#undef PG8_SB
#undef PG8_STAGE
#undef PG8_LDA
#undef PG8_LDB
#undef PG8_MMA
#undef PG8_WAIT_V
#undef PG8_WAIT_L
#undef PG8_BAR
#undef PG8_SCHED
}
}

template <bool UPPERM = false>
DI void transpose_item(const float* W, int K, int N, bf16_t* WT, LAS float* scr, int item, int nblk, int lane) {
    const int kb = item / nblk, nb = item % nblk, k0 = 64 * kb, n0 = 64 * nb;
    const int r0 = UPPERM ? ((n0 % DFF) / 128) * 256 + (n0 / DFF) * 128 + (n0 % 128) : n0;
    const int n4 = (lane & 15) * 4, kk = lane >> 4;
    const bool okn = (n0 + n4) < N;
    f32x4 v[16];
#pragma unroll
    for (int i = 0; i < 16; ++i) v[i] = okn ? __builtin_nontemporal_load((const f32x4*)(W + (size_t)(k0 + 4 * i + kk) * N + n0 + n4)) : (f32x4){0.f, 0.f, 0.f, 0.f};
#pragma unroll
    for (int i = 0; i < 16; ++i) { LAS float* d = scr + (4 * i + kk) * 65 + n4; d[0] = v[i].x; d[1] = v[i].y; d[2] = v[i].z; d[3] = v[i].w; }
    LDS_WAIT();
    const int c = lane & 7;
#pragma unroll
    for (int j = 0; j < 8; ++j) { const int n = (lane >> 3) + 8 * j; const LAS float* sp = scr + (8 * c) * 65 + n;
        u32x4 o; o.x = pk2(sp[0 * 65], sp[1 * 65]); o.y = pk2(sp[2 * 65], sp[3 * 65]); o.z = pk2(sp[4 * 65], sp[5 * 65]); o.w = pk2(sp[6 * 65], sp[7 * 65]);
        *(u32x4*)(WT + (size_t)(r0 + n) * K + k0 + 8 * c) = o; }
    LDS_WAIT();
}
DI void rms_row_bf16(const float* xrow, const float* w, bf16_t* orow, int lane) {
    const f32x4* xr = (const f32x4*)xrow + lane; const f32x4* wr = (const f32x4*)w + lane;
    f32x4 v[8]; float s = 0.f;
#pragma unroll
    for (int j = 0; j < 8; ++j) { v[j] = xr[64 * j]; s += (v[j].x * v[j].x + v[j].y * v[j].y) + (v[j].z * v[j].z + v[j].w * v[j].w); }
    const float rstd = rsqrtf(wave_sum(s) * (1.f / DM) + EPS);
    u32x2* o8 = (u32x2*)orow + lane;
#pragma unroll
    for (int j = 0; j < 8; ++j) { const f32x4 ww = wr[64 * j]; u32x2 o = {pk2(v[j].x * rstd * ww.x, v[j].y * rstd * ww.y), pk2(v[j].z * rstd * ww.z, v[j].w * rstd * ww.w)}; o8[64 * j] = o; }
}
DI void rms_row_f32(float* xrow, const float* w, int lane) {
    f32x4* xr = (f32x4*)xrow + lane; const f32x4* wr = (const f32x4*)w + lane;
    f32x4 v[8]; float s = 0.f;
#pragma unroll
    for (int j = 0; j < 8; ++j) { v[j] = xr[64 * j]; s += (v[j].x * v[j].x + v[j].y * v[j].y) + (v[j].z * v[j].z + v[j].w * v[j].w); }
    const float rstd = rsqrtf(wave_sum(s) * (1.f / DM) + EPS);
#pragma unroll
    for (int j = 0; j < 8; ++j) { const f32x4 ww = wr[64 * j]; __builtin_nontemporal_store(v[j] * rstd * ww, xr + 64 * j); }
}

DI void rot_item(int item, bf16_t* PROJ, const float* ROTC, const float* ROTS, bf16_t* KT, bf16_t* VT, LAS unsigned char* lds, int wv) {
    const int tid = tid_(wv); PROJ = lnd(PROJ); ROTC = lnd(ROTC); ROTS = lnd(ROTS); KT = lnd(KT); VT = lnd(VT);
    const int bh = item >> 6, tb = item & 63, bl = bh >> 3, h = bh & 7;
    const int t0 = tb * 64;
    LAS bf16_t* ldsK = (LAS bf16_t*)lds;
    LAS bf16_t* ldsV = (LAS bf16_t*)(lds + 128 * 72 * 2);
    const float lg = log2gamma(h);
    {
        const int t = tid >> 3, seg = tid & 7, pos = t0 + t;
        bf16_t* prow = PROJ + (size_t)(bl * SEQ + pos) * LDP;
        const f32x4 c0 = *(const f32x4*)(ROTC + pos * 64 + seg * 8), c1 = *(const f32x4*)(ROTC + pos * 64 + seg * 8 + 4);
        const f32x4 s0 = *(const f32x4*)(ROTS + pos * 64 + seg * 8), s1 = *(const f32x4*)(ROTS + pos * 64 + seg * 8 + 4);
        const float cs[8] = {c0.x, c0.y, c0.z, c0.w, c1.x, c1.y, c1.z, c1.w}, sn[8] = {s0.x, s0.y, s0.z, s0.w, s1.x, s1.y, s1.z, s1.w};
        {
            bf16_t* p = prow + C_RQ + h * 128 + seg * 8;
            const u32x4 a = *(const u32x4*)p, b = *(const u32x4*)(p + 64);
            float o1[8], o2[8];
#pragma unroll
            for (int j = 0; j < 4; ++j) { const float x1l = bflo(a[j]), x1h = bfhi(a[j]), x2l = bflo(b[j]), x2h = bfhi(b[j]);
                o1[2 * j] = (x1l * cs[2 * j] - x2l * sn[2 * j]) * 0.08838834764831845f; o1[2 * j + 1] = (x1h * cs[2 * j + 1] - x2h * sn[2 * j + 1]) * 0.08838834764831845f;
                o2[2 * j] = (x1l * sn[2 * j] + x2l * cs[2 * j]) * 0.08838834764831845f; o2[2 * j + 1] = (x1h * sn[2 * j + 1] + x2h * cs[2 * j + 1]) * 0.08838834764831845f; }
            u32x4 w1 = {pk2(o1[0], o1[1]), pk2(o1[2], o1[3]), pk2(o1[4], o1[5]), pk2(o1[6], o1[7])}, w2 = {pk2(o2[0], o2[1]), pk2(o2[2], o2[3]), pk2(o2[4], o2[5]), pk2(o2[6], o2[7])};
            *(u32x4*)p = w1; *(u32x4*)(p + 64) = w2;
        }
        {
            bf16_t* p = prow + C_RK + h * 128 + seg * 8;
            const u32x4 a = *(const u32x4*)p, b = *(const u32x4*)(p + 64);
            float o1[8], o2[8];
#pragma unroll
            for (int j = 0; j < 4; ++j) { const float x1l = bflo(a[j]), x1h = bfhi(a[j]), x2l = bflo(b[j]), x2h = bfhi(b[j]);
                o1[2 * j] = x1l * cs[2 * j] - x2l * sn[2 * j]; o1[2 * j + 1] = x1h * cs[2 * j + 1] - x2h * sn[2 * j + 1];
                o2[2 * j] = x1l * sn[2 * j] + x2l * cs[2 * j]; o2[2 * j + 1] = x1h * sn[2 * j + 1] + x2h * cs[2 * j + 1]; }
            u32x4 w1 = {pk2(o1[0], o1[1]), pk2(o1[2], o1[3]), pk2(o1[4], o1[5]), pk2(o1[6], o1[7])}, w2 = {pk2(o2[0], o2[1]), pk2(o2[2], o2[3]), pk2(o2[4], o2[5]), pk2(o2[6], o2[7])};
            *(u32x4*)p = w1; *(u32x4*)(p + 64) = w2;
            const float kw = exp2f(lg * (float)(127 - (pos & 127)));
#pragma unroll
            for (int j = 0; j < 8; ++j) { ldsK[(seg * 8 + j) * 72 + t] = (bf16_t)(pk2(o1[j] * kw, 0.f) & 0xffffu); ldsK[(64 + seg * 8 + j) * 72 + t] = (bf16_t)(pk2(o2[j] * kw, 0.f) & 0xffffu); }
        }
        {
            const bf16_t* p = prow + C_RV + h * 256 + seg * 32;
#pragma unroll
            for (int q = 0; q < 4; ++q) { const u32x4 a = *(const u32x4*)(p + q * 8);
#pragma unroll
                for (int j = 0; j < 4; ++j) { ldsV[(seg * 32 + q * 8 + 2 * j) * 72 + t] = (bf16_t)(a[j] & 0xffffu); ldsV[(seg * 32 + q * 8 + 2 * j + 1) * 72 + t] = (bf16_t)(a[j] >> 16); } }
        }
    }
    __syncthreads();
    {
        const int d = tid >> 2, ts = (tid & 3) * 16;
        const u32x4 a = *(const LAS u32x4*)(ldsK + d * 72 + ts), b = *(const LAS u32x4*)(ldsK + d * 72 + ts + 8);
        bf16_t* o = KT + (size_t)(bh * 128 + d) * SEQ + t0 + ts; *(u32x4*)o = a; *(u32x4*)(o + 8) = b;
        const int e = tid >> 1, tv = (tid & 1) * 32;
        bf16_t* ov = VT + (size_t)(bh * 256 + e) * SEQ + t0 + tv;
#pragma unroll
        for (int q = 0; q < 4; ++q) *(u32x4*)(ov + q * 8) = *(const LAS u32x4*)(ldsV + e * 72 + tv + q * 8);
    }
    __syncthreads();
}

DI void retA_item(int item, const bf16_t* KT, const bf16_t* VT, bf16_t* STATE, int wv) {
    KT = lnd(KT); VT = lnd(VT); STATE = lnd(STATE);
    const int tid = tid_(wv), wid = tid >> 6, lane = tid & 63, r32 = lane & 31, hi = lane >> 5;
    const int bh = item >> 5, c = item & 31;
    const bf16_t* vp = VT + (size_t)(bh * 256 + wid * 32 + r32) * SEQ + c * 128 + hi * 8;
    const bf16_t* kp = KT + (size_t)(bh * 128 + r32) * SEQ + c * 128 + hi * 8;
    f32x16 acc[4] = {};
#pragma unroll
    for (int ks = 0; ks < 8; ++ks) {
        const bf16x8 a = *(const bf16x8*)(vp + ks * 16);
#pragma unroll
        for (int dt = 0; dt < 4; ++dt) { const bf16x8 b = *(const bf16x8*)(kp + (size_t)dt * 32 * SEQ + ks * 16); acc[dt] = MFMA32(a, b, acc[dt]); }
    }
    bf16_t* so = STATE + (size_t)(bh * 32 + c) * 32768;
#pragma unroll
    for (int dt = 0; dt < 4; ++dt)
#pragma unroll
        for (int r = 0; r < 16; ++r) so[(((wid * 8 + dt * 2 + (r32 >> 4)) * 64 + ((r32 >> 3) & 1) * 32 + crow(r, hi)) << 3) + (r32 & 7)] = (bf16_t)(pk2(acc[dt][r], 0.f) & 0xffffu);
}
DI void retB_scan(bf16_t* STATE, int gtid, int wv) {
    STATE = lnd(STATE);
    const int bh = gtid >> 13, rem = gtid & 8191;
    const float dec = exp2f(log2gamma(bh & 7) * 128.f);
    float s0 = 0.f, s1 = 0.f, s2 = 0.f, s3 = 0.f;
    bf16_t* p = STATE + (size_t)bh * 32 * 32768 + (size_t)rem * 4;
    u32x2 kv[32];
#pragma unroll
    for (int c = 0; c < 32; ++c) kv[c] = *(const u32x2*)(p + (size_t)c * 32768);
#pragma unroll
    for (int c = 0; c < 32; ++c) {
        u32x2 o = {pk2(s0, s1), pk2(s2, s3)}; *(u32x2*)(p + (size_t)c * 32768) = o;
        s0 = s0 * dec + bflo(kv[c][0]); s1 = s1 * dec + bfhi(kv[c][0]); s2 = s2 * dec + bflo(kv[c][1]); s3 = s3 * dec + bfhi(kv[c][1]);
    }
}
DI void retC_item(int item, const bf16_t* PROJ, const bf16_t* VT, const bf16_t* STATE, const float* ret_w, bf16_t* ARET, LAS unsigned char* lds, int wv) {
    PROJ = lnd(PROJ); VT = lnd(VT); STATE = lnd(STATE); ret_w = lnd(ret_w); ARET = lnd(ARET);
    const int tid = tid_(wv), wid = tid >> 6, lane = tid & 63, r32 = lane & 31, hi = lane >> 5;
    const int bh = item >> 5, c = item & 31, bl = bh >> 3, h = bh & 7;
    const int nb = wid & 3, eh = wid >> 2;
    const float lg = log2gamma(h);
    const size_t rowbase = (size_t)bl * SEQ + c * 128;
    const int ntok = nb * 32 + r32;
    bf16x8 qf[8];
    { const bf16_t* qp = PROJ + (rowbase + ntok) * LDP + C_RQ + h * 128 + hi * 8;
#pragma unroll
      for (int ds = 0; ds < 8; ++ds) qf[ds] = *(const bf16x8*)(qp + ds * 16); }
    LAS unsigned char* ldsK = lds; LAS unsigned char* ldsV = lds + 32768;
    {
        const int kr = tid >> 4, kc = tid & 15;
        const bf16_t* ksrc = PROJ + (rowbase + kr) * LDP + C_RK + h * 128 + kc * 8;
        const bf16_t* vsrc = VT + (size_t)(bh * 256 + kr) * SEQ + c * 128 + kc * 8;
        u32x4 kv[4], vv[8];
#pragma unroll
        for (int j = 0; j < 4; ++j) kv[j] = *(const u32x4*)(ksrc + (size_t)j * 32 * LDP);
#pragma unroll
        for (int j = 0; j < 8; ++j) vv[j] = *(const u32x4*)(vsrc + (size_t)j * 32 * SEQ);
#pragma unroll
        for (int j = 0; j < 4; ++j) { const int row = j * 32 + kr; *(LAS u32x4*)(ldsK + row * 256 + ((kc ^ (row & 15)) << 4)) = kv[j]; }
#pragma unroll
        for (int j = 0; j < 8; ++j) { const int row = j * 32 + kr, x = row & 31; u32x2 lo = {vv[j][0], vv[j][1]}, hh = {vv[j][2], vv[j][3]};
            *(LAS u32x2*)(ldsV + row * 256 + (((2 * kc) ^ x) << 3)) = lo; *(LAS u32x2*)(ldsV + row * 256 + (((2 * kc + 1) ^ x) << 3)) = hh; }
    }
    __syncthreads();
    f32x16 o[4] = {};
    const int kx = r32 & 15;
    for (int mb = 0; mb <= nb; ++mb) {
        f32x16 pt = {};
        const LAS unsigned char* kb = ldsK + (mb * 32 + r32) * 256;
#pragma unroll
        for (int ds = 0; ds < 8; ++ds) pt = MFMA32(*(const LAS bf16x8*)(kb + (((2 * ds + hi) ^ kx) << 4)), qf[ds], pt);
#pragma unroll
        for (int r = 0; r < 16; ++r) { const int dd = ntok - (mb * 32 + crow(r, hi)); pt[r] = dd >= 0 ? pt[r] * exp2f(lg * (float)dd) : 0.f; }
#pragma unroll
        for (int s2 = 0; s2 < 2; ++s2) {
            u32x4 pw = {pk2(pt[8 * s2], pt[8 * s2 + 1]), pk2(pt[8 * s2 + 2], pt[8 * s2 + 3]), pk2(pt[8 * s2 + 4], pt[8 * s2 + 5]), pk2(pt[8 * s2 + 6], pt[8 * s2 + 7])};
            const bf16x8 pb = __builtin_bit_cast(bf16x8, pw);
            const int gq = 8 * mb + 4 * s2 + hi;
#pragma unroll
            for (int et = 0; et < 4; ++et) {
                const LAS unsigned char* vrow = ldsV + (eh * 128 + et * 32 + r32) * 256;
                const u32x2 lo = *(const LAS u32x2*)(vrow + ((gq ^ r32) << 3)), hh = *(const LAS u32x2*)(vrow + (((gq + 2) ^ r32) << 3));
                u32x4 aw = {lo[0], lo[1], hh[0], hh[1]};
                o[et] = MFMA32(__builtin_bit_cast(bf16x8, aw), pb, o[et]);
            }
        }
    }
    f32x16 cr[4] = {};
    { const bf16_t* sp = STATE + (size_t)(bh * 32 + c) * 32768 + (size_t)(eh * 4 * 8 * 64 + lane) * 8;
#pragma unroll
      for (int ds = 0; ds < 8; ++ds)
#pragma unroll
          for (int et = 0; et < 4; ++et) cr[et] = MFMA32(*(const bf16x8*)(sp + (size_t)((et * 8 + ds) * 64) * 8), qf[ds], cr[et]); }
    const float qd = exp2f(lg * (float)(ntok + 1));
    float ss = 0.f;
#pragma unroll
    for (int et = 0; et < 4; ++et)
#pragma unroll
        for (int r = 0; r < 16; ++r) { const float v = o[et][r] + cr[et][r] * qd; o[et][r] = v; ss += v * v; }
    ss = sum32(ss);
    LAS float* ex = (LAS float*)(lds + 133120);
    if (hi == 0) ex[wid * 32 + r32] = ss;
    __syncthreads();
    const float tot = ex[wid * 32 + r32] + ex[(wid ^ 4) * 32 + r32];
    const float rstd = rsqrtf(tot * (1.f / 256.f) + EPS);
    {
        LAS unsigned char* trow = lds + ntok * 1040 + (eh * 128 + 4 * hi) * 4;
#pragma unroll
        for (int et = 0; et < 4; ++et)
#pragma unroll
            for (int q = 0; q < 4; ++q) { f32x4 v = {o[et][4 * q] * rstd, o[et][4 * q + 1] * rstd, o[et][4 * q + 2] * rstd, o[et][4 * q + 3] * rstd}; *(LAS f32x4*)(trow + (et * 32 + 8 * q) * 4) = v; }
    }
    __syncthreads();
#pragma unroll
    for (int j = 0; j < 8; ++j) {
        const int p = tid + 512 * j, tok = p >> 5, e8 = (p & 31) * 8;
        const f32x4 a = *(const LAS f32x4*)(lds + tok * 1040 + e8 * 4), b = *(const LAS f32x4*)(lds + tok * 1040 + e8 * 4 + 16);
        const u32x4 g = *(const u32x4*)(PROJ + (rowbase + tok) * LDP + C_RG + h * 256 + e8);
        const f32x4 w0 = *(const f32x4*)(ret_w + h * 256 + e8), w1 = *(const f32x4*)(ret_w + h * 256 + e8 + 4);
        u32x4 ow = {pk2(a[0] * w0.x * siluf_(bflo(g[0])), a[1] * w0.y * siluf_(bfhi(g[0]))), pk2(a[2] * w0.z * siluf_(bflo(g[1])), a[3] * w0.w * siluf_(bfhi(g[1]))),
                    pk2(b[0] * w1.x * siluf_(bflo(g[2])), b[1] * w1.y * siluf_(bfhi(g[2]))), pk2(b[2] * w1.z * siluf_(bflo(g[3])), b[3] * w1.w * siluf_(bfhi(g[3])))};
        *(u32x4*)(ARET + (rowbase + tok) * DM + h * 256 + e8) = ow;
    }
    __syncthreads();
}

DI float gelu_tanh(float x) { const float u = 0.7978845608028654f * (x + 0.044715f * x * x * x); const float e = __expf(2.f * u); const float t = 1.f - 2.f / (e + 1.f); return 0.5f * x * (1.f + t); }
DI void cmp_item(int item, int hf, const bf16_t* PROJ, const float* pe_k, const float* pe_v, const bf16_t* W1K, const bf16_t* W1V, const bf16_t* W2K, const bf16_t* W2V,
                 float* KP, float* VP, LAS unsigned char* lds, int wv) {
    PROJ = lnd(PROJ); KP = lnd(KP); VP = lnd(VP);
    const int tid = tid_(wv), wid = tid >> 6, lane = tid & 63, fr = lane & 15, kq = lane >> 4;
    const int h2 = item & 1, rg = (item >> 1) & 15, g = (item >> 5) & 1, bl = (item >> 6) & 1, kv = item >> 7;
    const float* pe = lnd(kv ? pe_v : pe_k); const bf16_t* W1 = lnd(kv ? W1V : W1K); const bf16_t* W2 = lnd(kv ? W2V : W2K);
    const int ccol = (kv ? C_VC : C_KC) + g * 128;
    const int i_raw = rg * 16 + fr, ib = i_raw > 254 ? 254 : i_raw;
    const bf16_t* arow = PROJ + (size_t)(bl * SEQ + 16 * ib) * LDP + ccol + 8 * kq;
    const bf16_t* bp = W1 + (size_t)(h2 * 128 + fr) * 4096 + 8 * kq;
    f32x4 acc[8];
#pragma unroll
    for (int nt = 0; nt < 8; ++nt) acc[nt] = (f32x4){0.f, 0.f, 0.f, 0.f};
#define CMP_LOAD(XA, P0, P1, BF, kk_) do { const int ks_ = wid * 16 + (kk_), l_ = ks_ >> 2, d0_ = (ks_ & 3) * 32; XA = *(const u32x4*)(arow + (size_t)l_ * LDP + d0_); \
        const float* pp_ = pe + l_ * 128 + d0_ + 8 * kq; P0 = *(const f32x4*)pp_; P1 = *(const f32x4*)(pp_ + 4); \
        _Pragma("unroll") for (int nt = 0; nt < 8; ++nt) BF[nt] = *(const bf16x8*)(bp + (size_t)nt * 16 * 4096 + ks_ * 32); } while (0)
#define CMP_MMA(XA, P0, P1, BF) do { u32x4 aw = {pk2(bflo(XA[0]) + P0.x, bfhi(XA[0]) + P0.y), pk2(bflo(XA[1]) + P0.z, bfhi(XA[1]) + P0.w), pk2(bflo(XA[2]) + P1.x, bfhi(XA[2]) + P1.y), pk2(bflo(XA[3]) + P1.z, bfhi(XA[3]) + P1.w)}; \
        const bf16x8 af = __builtin_bit_cast(bf16x8, aw); _Pragma("unroll") for (int nt = 0; nt < 8; ++nt) acc[nt] = MFMA16(af, BF[nt], acc[nt]); } while (0)
    {
        u32x4 xaA, xaB; f32x4 pA0, pA1, pB0, pB1; bf16x8 bfA[8], bfB[8];
        CMP_LOAD(xaA, pA0, pA1, bfA, 0);
        for (int kk = 0; kk < 16; kk += 2) {
            CMP_LOAD(xaB, pB0, pB1, bfB, kk + 1);
            CMP_MMA(xaA, pA0, pA1, bfA);
            if (kk + 2 < 16) CMP_LOAD(xaA, pA0, pA1, bfA, kk + 2);
            CMP_MMA(xaB, pB0, pB1, bfB);
        }
    }
#undef CMP_LOAD
#undef CMP_MMA
    LAS float* red = (LAS float*)lds;
    LAS bf16_t* hid = (LAS bf16_t*)(lds + 65536);
#pragma unroll
    for (int nt = 0; nt < 8; ++nt)
#pragma unroll
        for (int r = 0; r < 4; ++r) red[(wid * 16 + 4 * kq + r) * 128 + nt * 16 + fr] = acc[nt][r];
    __syncthreads();
#pragma unroll
    for (int e = 0; e < 4; ++e) {
        const int idx = e * 512 + tid;
        float v = 0.f;
#pragma unroll
        for (int w = 0; w < 8; ++w) v += red[w * 2048 + idx];
        hid[(idx >> 7) * 136 + (idx & 127)] = (bf16_t)(pk2(gelu_tanh(v), 0.f) & 0xffffu);
    }
    __syncthreads();
    f32x4 o = {0.f, 0.f, 0.f, 0.f};
    const bf16_t* w2p = W2 + (size_t)(wid * 16 + fr) * 256 + h2 * 128 + 8 * kq;
#pragma unroll
    for (int ks = 0; ks < 4; ++ks) o = MFMA16(*(const LAS bf16x8*)(hid + fr * 136 + ks * 32 + 8 * kq), *(const bf16x8*)(w2p + ks * 32), o);
    const int bg = (hf * 2 + bl) * 2 + g;
    const int d = wid * 16 + fr;
    if (kv == 0) {
        float* kp = KP + (size_t)h2 * (8 * 256 * 128);
#pragma unroll
        for (int r = 0; r < 4; ++r) { const int i = rg * 16 + 4 * kq + r; kp[((size_t)bg * 256 + i) * 128 + d] = i < 255 ? o[r] : 0.f; }
    } else {
        float* vp = VP + (size_t)h2 * (8 * 128 * 256);
        const int i0 = rg * 16 + 4 * kq;
        f32x4 w = {o[0], o[1], o[2], (i0 + 3 < 255) ? o[3] : 0.f};
        *(f32x4*)(vp + ((size_t)bg * 128 + d) * 256 + i0) = w;
    }
    __syncthreads();
}

DI void cattn_item(int item, int hf, const bf16_t* PROJ, const float* KP, const float* VP, float* NSAF, unsigned* SEL, LAS unsigned char* lds, int wv) {
    PROJ = lnd(PROJ); KP = lnd(KP); VP = lnd(VP); NSAF = lnd(NSAF); SEL = lnd(SEL);
    const int tid = tid_(wv), wid = tid >> 6, lane = tid & 63, r32 = lane & 31, hi = lane >> 5;
    const int g = (item >> 7) & 1, bl = item >> 8;
    const int tb = bl ? 127 - (item & 127) : (item & 127);
    const int bg = (hf * 2 + bl) * 2 + g, head = g * 8 + wid;
    const int t = tb * 32 + r32;
    const size_t lrow = (size_t)bl * SEQ + t;
    const int ntile = (tb >> 4) + 1;
    LAS unsigned char* ldsK = lds; LAS unsigned char* ldsV = lds + 65536;
    bf16x8 qf[8];
    { const bf16_t* qp = PROJ + lrow * LDP + C_NQ + head * 128 + hi * 8;
#pragma unroll
      for (int ds = 0; ds < 8; ++ds) qf[ds] = *(const bf16x8*)(qp + ds * 16); }
    {
        const int kr = tid >> 4, kc = tid & 15;
        const float* ksrc = KP + ((size_t)bg * 256 + kr) * 128 + kc * 8;
        const int vr = tid >> 2, vc = tid & 3;
        const float* vsrc = VP + ((size_t)bg * 128 + vr) * 256 + vc * 8;
#pragma unroll
        for (int jb = 0; jb < 8; jb += 4) {
            if (jb < ntile) {
                f32x4 ka[4], kb2[4], va[4], vb2[4];
#pragma unroll
                for (int jj = 0; jj < 4; ++jj) {
                    const int j = jb + jj;
                    if (j < ntile) {
                        const float* kp0 = ksrc + (size_t)j * 32 * 128; const float* kp1 = kp0 + 8 * 256 * 128;
                        ka[jj] = *(const f32x4*)kp0 + *(const f32x4*)kp1; kb2[jj] = *(const f32x4*)(kp0 + 4) + *(const f32x4*)(kp1 + 4);
                        const float* vp0 = vsrc + j * 32; const float* vp1 = vp0 + 8 * 128 * 256;
                        va[jj] = *(const f32x4*)vp0 + *(const f32x4*)vp1; vb2[jj] = *(const f32x4*)(vp0 + 4) + *(const f32x4*)(vp1 + 4);
                    }
                }
#pragma unroll
                for (int jj = 0; jj < 4; ++jj) {
                    const int j = jb + jj;
                    if (j < ntile) {
                        const int row = j * 32 + kr;
                        u32x4 kv = {pk2(ka[jj][0], ka[jj][1]), pk2(ka[jj][2], ka[jj][3]), pk2(kb2[jj][0], kb2[jj][1]), pk2(kb2[jj][2], kb2[jj][3])};
                        *(LAS u32x4*)(ldsK + row * 256 + ((kc ^ (row & 15)) << 4)) = kv;
                        const int g0 = 2 * (vc + 4 * j), x = vr & 31;
                        u32x2 lo = {pk2(va[jj][0], va[jj][1]), pk2(va[jj][2], va[jj][3])}, hh = {pk2(vb2[jj][0], vb2[jj][1]), pk2(vb2[jj][2], vb2[jj][3])};
                        *(LAS u32x2*)(ldsV + vr * 512 + ((g0 ^ x) << 3)) = lo;
                        *(LAS u32x2*)(ldsV + vr * 512 + (((g0 + 1) ^ x) << 3)) = hh;
                    }
                }
            }
        }
    }
    __syncthreads();
    f32x16 s[8];
    const int imax = (t - 31) >> 4;
    float mx = -__builtin_inff();
    const int kx = r32 & 15;
#pragma unroll
    for (int kt = 0; kt < 8; ++kt) {
        s[kt] = f32x16{};
        if (kt < ntile) {
            const LAS unsigned char* kb = ldsK + (kt * 32 + r32) * 256;
#pragma unroll
            for (int ds = 0; ds < 8; ++ds) s[kt] = MFMA32(*(const LAS bf16x8*)(kb + (((2 * ds + hi) ^ kx) << 4)), qf[ds], s[kt]);
        }
#pragma unroll
        for (int r = 0; r < 16; ++r) { const int i = kt * 32 + crow(r, hi); const float v = (kt < ntile && i <= imax) ? s[kt][r] * 0.08838834764831845f : -__builtin_inff(); s[kt][r] = v; mx = fmaxf(mx, v); }
    }
    mx = fmaxf(mx, xor32(mx, hi));
    if (mx == -__builtin_inff()) mx = 0.f;
    float sum = 0.f;
#pragma unroll
    for (int kt = 0; kt < 8; ++kt)
#pragma unroll
        for (int r = 0; r < 16; ++r) { const float p = __expf(s[kt][r] - mx); s[kt][r] = p; sum += p; }
    sum = sum32(sum);
    const float inv = 1.f / fmaxf(sum, 1e-30f);
    f32x16 o[4] = {};
#pragma unroll
    for (int kt = 0; kt < 8; ++kt) {
#pragma unroll
        for (int r = 0; r < 16; ++r) s[kt][r] *= inv;
        if (kt < ntile) {
#pragma unroll
            for (int st = 0; st < 2; ++st) {
                u32x4 pw = {pk2(s[kt][8 * st], s[kt][8 * st + 1]), pk2(s[kt][8 * st + 2], s[kt][8 * st + 3]), pk2(s[kt][8 * st + 4], s[kt][8 * st + 5]), pk2(s[kt][8 * st + 6], s[kt][8 * st + 7])};
                const bf16x8 pb = __builtin_bit_cast(bf16x8, pw);
                const int gq = 8 * kt + 4 * st + hi;
#pragma unroll
                for (int dt = 0; dt < 4; ++dt) {
                    const LAS unsigned char* vrow = ldsV + (dt * 32 + r32) * 512;
                    const u32x2 lo = *(const LAS u32x2*)(vrow + ((gq ^ r32) << 3)), hh = *(const LAS u32x2*)(vrow + (((gq + 2) ^ r32) << 3));
                    u32x4 aw = {lo[0], lo[1], hh[0], hh[1]};
                    o[dt] = MFMA32(__builtin_bit_cast(bf16x8, aw), pb, o[dt]);
                }
            }
        }
    }
    {
        const float gate = sigmoidf_(bf2f(PROJ[lrow * LDP + C_NG + head * 3 + 0]));
        float* op = NSAF + lrow * DM + head * 128;
#pragma unroll
        for (int dt = 0; dt < 4; ++dt)
#pragma unroll
            for (int q = 0; q < 4; ++q) { f32x4 v = {o[dt][4 * q] * gate, o[dt][4 * q + 1] * gate, o[dt][4 * q + 2] * gate, o[dt][4 * q + 3] * gate}; *(f32x4*)(op + dt * 32 + 8 * q + 4 * hi) = v; }
    }
    __syncthreads();
    LAS float* slab = (LAS float*)lds;
    {
        float plprev = 0.f;
#pragma unroll
        for (int kt = 0; kt < 8; ++kt)
#pragma unroll
            for (int q = 0; q < 4; ++q) {
                const float gsum = (s[kt][4 * q] + s[kt][4 * q + 1]) + (s[kt][4 * q + 2] + s[kt][4 * q + 3]);
                const float pl = xor32(s[kt][4 * q + 3], hi);
                const float add = hi ? pl : plprev;
                slab[(wid * 32 + r32) * 65 + 8 * kt + 2 * q + hi] = gsum + add;
                plprev = pl;
            }
    }
    __syncthreads();
    LAS float* imps = (LAS float*)(lds + 131072);
    const int c = tid >> 4, j4 = (tid & 15) * 4;
#pragma unroll
    for (int k = 0; k < 4; ++k) { float v = 0.f;
#pragma unroll
        for (int w = 0; w < 8; ++w) v += slab[(w * 32 + c) * 65 + j4 + k];
        imps[c * 65 + j4 + k] = v; }
    __syncthreads();
    {
        const int tt = tb * 32 + c, cur = tt >> 6;
        float myv[4];
#pragma unroll
        for (int k = 0; k < 4; ++k) { const int sb = j4 + k; myv[k] = (sb == 0 || sb == cur || sb == cur - 1) ? 1e4f : (sb > cur ? -1e4f : imps[c * 65 + sb]); }
        int rank[4] = {0, 0, 0, 0};
        for (int sb2 = 0; sb2 < 64; ++sb2) {
            const float v2 = (sb2 == 0 || sb2 == cur || sb2 == cur - 1) ? 1e4f : (sb2 > cur ? -1e4f : imps[c * 65 + sb2]);
#pragma unroll
            for (int k = 0; k < 4; ++k) rank[k] += (v2 > myv[k] || (v2 == myv[k] && sb2 < j4 + k)) ? 1 : 0;
        }
        unsigned lo = 0, hh = 0;
#pragma unroll
        for (int k = 0; k < 4; ++k) { const int sb = j4 + k; if (rank[k] < 16 && sb <= cur) { if (sb < 32) lo |= 1u << sb; else hh |= 1u << (sb - 32); } }
        lo |= swzu<1>(lo); hh |= swzu<1>(hh); lo |= swzu<2>(lo); hh |= swzu<2>(hh); lo |= swzu<4>(lo); hh |= swzu<4>(hh); lo |= swzu<8>(lo); hh |= swzu<8>(hh);
        if ((tid & 15) == 0) { u32x2 w = {lo, hh}; *(u32x2*)(SEL + ((size_t)bg * SEQ + tt) * 2) = w; }
    }
    __syncthreads();
}

namespace att {
constexpr float SCALE = 0.08838834764831845f;
constexpr int NW = 8, QBLK = 32, KVBLK = 64, QB = 256, D = 128;
constexpr int SHM_V = KVBLK * D * 2, SHM_K = KVBLK * D * 2;
constexpr int LDS_NEED = 2 * SHM_V + 2 * SHM_K + NW * 64 * 4;
constexpr float THR = 8.f;
#define KSWZ(row, colB) ((row) * 256 + ((colB) ^ (((row) & 7) << 4)))
#define SBAR() __builtin_amdgcn_sched_barrier(0)
DI int v_st(int k, int c) { const int kk = (k & ~0xC) | ((k & 4) << 1) | ((k & 8) >> 1); return ((kk >> 3) * 4 + (c >> 5)) * 512 + ((kk & 7) * 32 + (c & 31)) * 2; }
DI int v_rd_base(int lane) { return ((lane & 3) << 3) | (((lane >> 2) & 3) << 6) | (((lane >> 4) & 1) << 5) | (((lane >> 5) & 1) << 8); }
constexpr int v_rd_off(int d0, int ks, int half) { return d0 * 512 + ks * 4096 + half * 2048; }
DI unsigned cvtpk(float lo, float hi) { unsigned r; asm volatile("v_cvt_pk_bf16_f32 %0, %1, %2" : "=v"(r) : "v"(lo), "v"(hi)); return r; }
DI bf16x8 load8(const bf16_t* p) { return *reinterpret_cast<const bf16x8*>(p); }
DI void mask_tile(f32x16& p0, f32x16& p1, int dq, unsigned W) {
    const float NEG = -__builtin_inff();
#pragma unroll
    for (int r = 0; r < 16; ++r) {
        const int c = (r & 3) + 8 * (r >> 2);
        if ((unsigned)(dq - c) >= W) p0[r] = NEG;
        if ((unsigned)(dq - c - 32) >= W) p1[r] = NEG;
    }
}
DI void partialSM(f32x16& p0, f32x16& p1, float& m_reg, float& mn, float& alpha) {
    float pmax = p0[0]; for (int r = 1; r < 16; ++r) pmax = fmaxf(pmax, p0[r]); for (int r = 0; r < 16; ++r) pmax = fmaxf(pmax, p1[r]);
    { auto rr = __builtin_amdgcn_permlane32_swap(__float_as_uint(pmax), __float_as_uint(pmax), false, false);
      pmax = fmaxf(__uint_as_float(rr[0]), __uint_as_float(rr[1])); }
    constexpr float C2 = 1.4426950408889634f * SCALE;
    if (__builtin_expect(__all((pmax - m_reg) * SCALE <= THR), 1)) { mn = m_reg; alpha = 1.f; }
    else { mn = fmaxf(m_reg, pmax); alpha = __builtin_amdgcn_exp2f((m_reg - mn) * C2); m_reg = mn; }
    const float mnL = -mn * C2;
    for (int r = 0; r < 16; ++r) p0[r] = fmaf(p0[r], C2, mnL); for (int r = 0; r < 16; ++r) p1[r] = fmaf(p1[r], C2, mnL);
    for (int r = 0; r < 16; ++r) p0[r] = __builtin_amdgcn_exp2f(p0[r]);
}
DI void finishSM(f32x16& p0, f32x16& p1, float alpha, float& l_reg, bf16x8& pa0, bf16x8& pa1, bf16x8& pa2, bf16x8& pa3) {
    for (int r = 0; r < 16; ++r) p1[r] = __builtin_amdgcn_exp2f(p1[r]);
    float ps = 0; for (int r = 0; r < 16; ++r) ps += p0[r]; for (int r = 0; r < 16; ++r) ps += p1[r];
    { auto rr = __builtin_amdgcn_permlane32_swap(__float_as_uint(ps), __float_as_uint(ps), false, false);
      ps = __uint_as_float(rr[0]) + __uint_as_float(rr[1]); }
    l_reg = l_reg * alpha + ps;
#define PK4(P, B_, OUT) do { unsigned a0 = cvtpk(P[B_+0], P[B_+1]), a1 = cvtpk(P[B_+2], P[B_+3]);                          \
        unsigned b0 = cvtpk(P[B_+4], P[B_+5]), b1 = cvtpk(P[B_+6], P[B_+7]);                                             \
        auto r0 = __builtin_amdgcn_permlane32_swap(a0, b0, false, false); auto r1 = __builtin_amdgcn_permlane32_swap(a1, b1, false, false); \
        u32x4 w = {r0[0], r1[0], r0[1], r1[1]}; OUT = *reinterpret_cast<bf16x8*>(&w); } while (0)
    PK4(p0, 0, pa0); PK4(p0, 8, pa1); PK4(p1, 0, pa2); PK4(p1, 8, pa3);
#undef PK4
}
template <int KB>
DI void qkt(f32x16& p0, f32x16& p1, const char* K_lds, int r32, int hi, const bf16x8* qr) {
    p0 = f32x16{}; p1 = f32x16{};
    const char* kb[4];
#pragma unroll
    for (int dd = 0; dd < 4; ++dd) kb[dd] = K_lds + KB * SHM_K + KSWZ(r32, (dd * 16 + hi * 8) * 2);
#pragma unroll
    for (int d0 = 0; d0 < 8; ++d0) { const char* a = kb[d0 & 3] + (d0 >> 2) * 128;
        bf16x8 b0 = *reinterpret_cast<const bf16x8*>(a);
        bf16x8 b1 = *reinterpret_cast<const bf16x8*>(a + 32 * 256);
        p0 = __builtin_amdgcn_mfma_f32_32x32x16_bf16(b0, qr[d0], p0, 0, 0, 0);
        p1 = __builtin_amdgcn_mfma_f32_32x32x16_bf16(b1, qr[d0], p1, 0, 0, 0); }
}
template <int VB>
DI void pv_tile(f32x16* o, int vb0, bf16x8 pa0, bf16x8 pa1, bf16x8 pa2, bf16x8 pa3) {
#define TRRD(dst, off) asm volatile("ds_read_b64_tr_b16 %0, %1 offset:%2" : "=&v"(dst) : "v"(vb0), "i"(off) : "memory")
#define PV_D0(d0) do { s16x4 l0, l1, l2, l3, h0, h1, h2, h3; constexpr int b_ = VB * SHM_V + v_rd_off(d0, 0, 0); \
        TRRD(l0, b_); TRRD(h0, b_ + 2048); TRRD(l1, b_ + 4096); TRRD(h1, b_ + 6144); TRRD(l2, b_ + 8192); TRRD(h2, b_ + 10240); TRRD(l3, b_ + 12288); TRRD(h3, b_ + 14336); \
        asm volatile("s_waitcnt lgkmcnt(0)" ::: "memory"); SBAR();   \
        o[d0] = __builtin_amdgcn_mfma_f32_32x32x16_bf16(pa0, (bf16x8){l0[0], l0[1], l0[2], l0[3], h0[0], h0[1], h0[2], h0[3]}, o[d0], 0, 0, 0);   \
        o[d0] = __builtin_amdgcn_mfma_f32_32x32x16_bf16(pa1, (bf16x8){l1[0], l1[1], l1[2], l1[3], h1[0], h1[1], h1[2], h1[3]}, o[d0], 0, 0, 0);   \
        o[d0] = __builtin_amdgcn_mfma_f32_32x32x16_bf16(pa2, (bf16x8){l2[0], l2[1], l2[2], l2[3], h2[0], h2[1], h2[2], h2[3]}, o[d0], 0, 0, 0);   \
        o[d0] = __builtin_amdgcn_mfma_f32_32x32x16_bf16(pa3, (bf16x8){l3[0], l3[1], l3[2], l3[3], h3[0], h3[1], h3[2], h3[3]}, o[d0], 0, 0, 0); } while (0)
    PV_D0(0); PV_D0(1); PV_D0(2); PV_D0(3);
#undef PV_D0
#undef TRRD
}
struct BlockRef { const bf16_t* Q; const bf16_t* K; const bf16_t* V; float* Of; bf16_t* Ob; const unsigned* sel; const bf16_t* gate; int P0; int W; int mode; };
struct Seam { bf16x8 qr[8]; bf16x8 st_v0, st_v1, st_k0, st_k1; };
DI int swa_jlo(int P0, int W) { const int lowk = P0 - W + 1; return lowk > 0 ? lowk / KVBLK : 0; }
#define ROW(p, k0, rr) ((p) + (size_t)((k0) + (rr)) * LDP + sc)
#define VMW() asm volatile("s_waitcnt vmcnt(0)" ::: "memory")
#define VMWN(n) asm volatile("s_waitcnt vmcnt(%0)" :: "i"(n) : "memory")
#define SLOAD_H(Kp, Vp, k0) do { S.st_v0 = load8(ROW(Vp, k0, sr)); S.st_v1 = load8(ROW(Vp, k0, 32 + sr));              \
                         S.st_k0 = load8(ROW(Kp, k0, sr)); S.st_k1 = load8(ROW(Kp, k0, 32 + sr)); } while (0)
#define SWRITE_HK(bf) do { *(bf16x8*)(K_lds + (bf) * SHM_K + kws) = S.st_k0; *(bf16x8*)(K_lds + (bf) * SHM_K + kws + 32 * 256) = S.st_k1; } while (0)
#define SWRITE_HV(bf) do { *(bf16x8*)(V_lds + (bf) * SHM_V + vst0) = S.st_v0; *(bf16x8*)(V_lds + (bf) * SHM_V + vst1) = S.st_v1; } while (0)
#define SWRITE_H(bf) do { SWRITE_HV(bf); SWRITE_HK(bf); } while (0)
DI BlockRef make_ref(int L, int step, int hf, const bf16_t* PROJ, float* NSAF, bf16_t* NSA, const unsigned* SEL) {
    const int y = L & 7, head = (L >> 3) & 15, bl = L >> 7, g = head >> 3;
    const int qb = (step & 2) ? 15 - y : y, win = step & 1;
    const int P0 = qb * QB;
    const size_t lrow0 = (size_t)bl * SEQ;
    BlockRef r;
    r.Q = PROJ + (lrow0 + P0) * LDP + C_NQ + head * 128;
    r.K = PROJ + lrow0 * LDP + (win ? C_KW : C_KS) + g * 128;
    r.V = PROJ + lrow0 * LDP + (win ? C_VW : C_VS) + g * 128;
    r.Of = NSAF + (lrow0 + P0) * DM + head * 128;
    r.Ob = NSA + (lrow0 + P0) * DM + head * 128;
    r.sel = win ? nullptr : SEL + ((size_t)((hf * 2 + bl) * 2 + g) * SEQ + P0) * 2;
    r.gate = PROJ + (lrow0 + P0) * LDP + C_NG + head * 3 + (win ? 2 : 1);
    r.P0 = P0; r.W = win ? 512 : (1 << 30); r.mode = win;
    return r;
}
DI void prime(const BlockRef& cur, char* lds, Seam& S, int wv) {
    const int tid = tid_(wv), wid = __builtin_amdgcn_readfirstlane(tid >> 6), lane = tid & 63, r32 = lane & 31, hi = lane >> 5;
    const int sr = tid >> 4, sc = (tid & 15) * 8, kws = KSWZ(sr, sc * 2); char* K_lds = lds + 2 * SHM_V;
    const int kb0 = swa_jlo(cur.P0, cur.W) * KVBLK;
    for (int d0 = 0; d0 < 8; ++d0) S.qr[d0] = load8(cur.Q + (size_t)(wid * QBLK + r32) * LDP + d0 * 16 + hi * 8);
    SLOAD_H(cur.K, cur.V, kb0); VMW(); SWRITE_HK(0);
    __syncthreads();
}
DI void block(const BlockRef& cur, int Ln, int stepn, int hf, const bf16_t* PROJ, float* NSAF, bf16_t* NSA, const unsigned* SEL, int skv, char* lds, Seam& S, int wv) {
    const int tid = tid_(wv), wid = __builtin_amdgcn_readfirstlane(tid >> 6), lane = tid & 63, r32 = lane & 31, hi = lane >> 5;
    const int W = cur.W;
    const int j_lo = swa_jlo(cur.P0, W);
    int j_hi = (cur.P0 + QB - 1) / KVBLK + 1; if (j_hi > skv / KVBLK) j_hi = skv / KVBLK;
    const int NT_ = j_hi - j_lo;
    const int qlo = cur.P0 + wid * QBLK, qm = qlo + r32 - 4 * hi;
    char* V_lds = lds; char* K_lds = lds + 2 * SHM_V;
    float* ws = (float*)(lds + 2 * SHM_V + 2 * SHM_K) + wid * 64; float* li_l = ws, * al_l = ws + 32;
    float m_reg = -1e30f, l_reg = 0; f32x16 o[4] = {};
    const int sr = tid >> 4, sc = (tid & 15) * 8, vst0 = v_st(sr, sc), vst1 = v_st(32 + sr, sc), kws = KSWZ(sr, sc * 2);
    const int vb0 = (int)(uintptr_t)V_lds + v_rd_base(lane);
    const bf16_t* Kh = cur.K; const bf16_t* Vh = cur.V;
    unsigned long long selm = ~0ull;
    if (cur.sel) { const u32x2 w = *(const u32x2*)(cur.sel + 2 * (wid * QBLK + r32)); selm = ((unsigned long long)w[1] << 32) | w[0]; }
#define RESC(a) do { if (__any((a) < 1.f)) { if (hi == 0) al_l[r32] = (a); asm volatile("s_waitcnt lgkmcnt(0)" ::: "memory");              \
                     for (int d_ = 0; d_ < 4; ++d_) for (int r = 0; r < 16; ++r) o[d_][r] *= al_l[crow(r, hi)]; } } while (0)
#define KBASE(t) ((j_lo + (t)) * KVBLK)
#define MASKT(P0_, P1_, t) do { const int kb_ = KBASE(t); if (kb_ + KVBLK - 1 > qlo || kb_ <= qlo + QBLK - 1 - W) mask_tile(P0_, P1_, qm - kb_, (unsigned)W); \
        if (cur.sel) { if (!((selm >> (j_lo + (t))) & 1ull)) { const float NEG_ = -__builtin_inff(); for (int r = 0; r < 16; ++r) { P0_[r] = NEG_; P1_[r] = NEG_; } } } } while (0)
    constexpr int NQL = 8;
#define SEAM_K0() do { VMWN(NQL); SWRITE_HK(0); SBAR(); } while (0)
    f32x16 pA0, pA1, pB0, pB1; float mnA, mnB, alA, alB; bf16x8 pa0, pa1, pa2, pa3;
    SWRITE_HV(0); SBAR();
    if (NT_ > 1) { SLOAD_H(Kh, Vh, KBASE(1)); }
    SBAR(); qkt<0>(pA0, pA1, K_lds, r32, hi, S.qr);
    MASKT(pA0, pA1, 0); partialSM(pA0, pA1, m_reg, mnA, alA);
    if (NT_ > 1) { VMW(); SWRITE_H(1); }
    __syncthreads();
#define HALF_STEP(PX0, PX1, mnX, alX, PY0, PY1, alY, t, KB, VB, SB) do {                                                      \
        SBAR(); qkt<KB>(PX0, PX1, K_lds, r32, hi, S.qr);                                             \
        finishSM(PY0, PY1, alY, l_reg, pa0, pa1, pa2, pa3); SBAR();                                                           \
        if ((t) + 1 < NT_) { SLOAD_H(Kh, Vh, KBASE((t) + 1)); SBAR(); }                                               \
        pv_tile<VB>(o, vb0, pa0, pa1, pa2, pa3); MASKT(PX0, PX1, (t)); partialSM(PX0, PX1, m_reg, mnX, alX);                                        \
        __syncthreads();                                                                                                      \
        if ((t) + 1 < NT_) { VMW(); SWRITE_H(SB); }                                                                          \
        RESC(alX); __syncthreads(); } while (0)
    for (int t = 1; t + 1 < NT_; t += 2) {
        HALF_STEP(pB0, pB1, mnB, alB, pA0, pA1, alA, t, 1, 0, 0);
        HALF_STEP(pA0, pA1, mnA, alA, pB0, pB1, alB, t + 1, 0, 1, 1);
    }
    const bool even = (NT_ & 1) == 0;
    if (even) { SBAR(); qkt<1>(pB0, pB1, K_lds, r32, hi, S.qr); SBAR(); }
    const BlockRef nxt = make_ref(Ln, stepn, hf, PROJ, NSAF, NSA, SEL);
    const int kbn = swa_jlo(nxt.P0, nxt.W) * KVBLK;
    SLOAD_H(nxt.K, nxt.V, kbn); SBAR();
#pragma unroll
    for (int d0 = 0; d0 < 8; ++d0) S.qr[d0] = load8(nxt.Q + (size_t)(wid * QBLK + r32) * LDP + d0 * 16 + hi * 8);
    SBAR();
    finishSM(pA0, pA1, alA, l_reg, pa0, pa1, pa2, pa3); SBAR();
    pv_tile<0>(o, vb0, pa0, pa1, pa2, pa3);
    if (even) { MASKT(pB0, pB1, NT_ - 1); partialSM(pB0, pB1, m_reg, mnB, alB); __syncthreads(); RESC(alB);
        finishSM(pB0, pB1, alB, l_reg, pa0, pa1, pa2, pa3); SBAR(); pv_tile<1>(o, vb0, pa0, pa1, pa2, pa3); }
    SBAR(); SEAM_K0();
    { const float gatev = 1.f / (1.f + __expf(-bf2f(cur.gate[(size_t)(wid * QBLK + r32) * LDP]))); if (hi == 0) li_l[r32] = gatev / l_reg; } asm volatile("s_waitcnt lgkmcnt(0)" ::: "memory");
    float rli[16];
#pragma unroll
    for (int r = 0; r < 16; ++r) rli[r] = li_l[crow(r, hi)];
    float* Ow = cur.Of + (size_t)(wid * QBLK) * DM;
    if (cur.mode == 0) {
#pragma unroll
        for (int r = 0; r < 16; ++r) { const int orow = crow(r, hi);
#pragma unroll
            for (int d0 = 0; d0 < 4; ++d0) { float* p = Ow + (size_t)orow * DM + d0 * 32 + r32; *p = *p + o[d0][r] * rli[r]; } }
    } else {
        bf16_t* Obw = cur.Ob + (size_t)(wid * QBLK) * DM;
#pragma unroll
        for (int r = 0; r < 16; ++r) { const int orow = crow(r, hi);
#pragma unroll
            for (int d0 = 0; d0 < 4; ++d0) { const float v = o[d0][r] * rli[r] + Ow[(size_t)orow * DM + d0 * 32 + r32];
                const float vn = swz<1>(v);
                if ((r32 & 1) == 0) *(unsigned*)(Obw + (size_t)orow * DM + d0 * 32 + r32) = pk2(v, vn); } }
    }
    __syncthreads();
#undef RESC
#undef KBASE
#undef MASKT
#undef SEAM_K0
#undef HALF_STEP
}
#undef ROW
#undef VMW
#undef VMWN
#undef SLOAD_H
#undef SWRITE_HK
#undef SWRITE_HV
#undef SWRITE_H
DI void phase(int hf, const bf16_t* PROJ, float* NSAF, bf16_t* NSA, const unsigned* SEL, char* lds, int bid, int G, int wv) {
    const int total = 2 * 16 * 8;
    int L = bid; if (L >= total) return;
    int step = 0;
    BlockRef cur = make_ref(L, 0, hf, PROJ, NSAF, NSA, SEL);
    Seam S;
    prime(cur, lds, S, wv);
    for (;;) {
        int Ln = L, stepn = step + 1;
        if (stepn == 4) { stepn = 0; Ln = L + G; }
        const bool last = (stepn == 0 && Ln >= total);
        if (last) { Ln = L; stepn = step; }
        block(cur, Ln, stepn, hf, PROJ, NSAF, NSA, SEL, SEQ, lds, S, wv);
        if (last) break;
        L = Ln; step = stepn; cur = make_ref(L, step, hf, PROJ, NSAF, NSA, SEL);
    }
}
}

DI void conv_unit(int unit, const bf16_t* __restrict__ U, const float* __restrict__ cw, const float* __restrict__ cb, bf16_t* __restrict__ ACT) {
    const int cgp = unit % (DFF / 8), rb = unit / (DFF / 8);
    const int r0 = rb * 16, col = cgp * 8;
    float wa[3][8], wb[3][8], ba[8], bb[8];
#pragma unroll
    for (int k = 0; k < 3; ++k) { const f32x4 a0 = *(const f32x4*)(cw + k * DFF2 + col), a1 = *(const f32x4*)(cw + k * DFF2 + col + 4), b0 = *(const f32x4*)(cw + k * DFF2 + DFF + col), b1 = *(const f32x4*)(cw + k * DFF2 + DFF + col + 4);
#pragma unroll
        for (int j = 0; j < 4; ++j) { wa[k][j] = a0[j]; wa[k][4 + j] = a1[j]; wb[k][j] = b0[j]; wb[k][4 + j] = b1[j]; } }
    { const f32x4 a0 = *(const f32x4*)(cb + col), a1 = *(const f32x4*)(cb + col + 4), b0 = *(const f32x4*)(cb + DFF + col), b1 = *(const f32x4*)(cb + DFF + col + 4);
#pragma unroll
      for (int j = 0; j < 4; ++j) { ba[j] = a0[j]; ba[4 + j] = a1[j]; bb[j] = b0[j]; bb[4 + j] = b1[j]; } }
    u32x4 a2 = {0, 0, 0, 0}, a1 = {0, 0, 0, 0}, b2 = {0, 0, 0, 0}, b1 = {0, 0, 0, 0};
    if ((r0 & (SEQ - 1)) != 0) { const bf16_t* p = U + (size_t)(r0 - 2) * DFF2 + col; a2 = *(const u32x4*)p; b2 = *(const u32x4*)(p + DFF); a1 = *(const u32x4*)(p + DFF2); b1 = *(const u32x4*)(p + DFF2 + DFF); }
#pragma unroll
    for (int rr = 0; rr < 16; rr += 8) {
        u32x4 av[8], bv[8];
#pragma unroll
        for (int r = 0; r < 8; ++r) { const bf16_t* p = U + (size_t)(r0 + rr + r) * DFF2 + col; av[r] = *(const u32x4*)p; bv[r] = *(const u32x4*)(p + DFF); }
#pragma unroll
        for (int r = 0; r < 8; ++r) {
            const u32x4 a0 = av[r], b0 = bv[r];
            float res[8];
#pragma unroll
            for (int j = 0; j < 4; ++j) {
                const float ua0 = wa[0][2 * j] * bflo(a2[j]) + wa[1][2 * j] * bflo(a1[j]) + wa[2][2 * j] * bflo(a0[j]) + ba[2 * j];
                const float ua1 = wa[0][2 * j + 1] * bfhi(a2[j]) + wa[1][2 * j + 1] * bfhi(a1[j]) + wa[2][2 * j + 1] * bfhi(a0[j]) + ba[2 * j + 1];
                const float ub0 = wb[0][2 * j] * bflo(b2[j]) + wb[1][2 * j] * bflo(b1[j]) + wb[2][2 * j] * bflo(b0[j]) + bb[2 * j];
                const float ub1 = wb[0][2 * j + 1] * bfhi(b2[j]) + wb[1][2 * j + 1] * bfhi(b1[j]) + wb[2][2 * j + 1] * bfhi(b0[j]) + bb[2 * j + 1];
                res[2 * j] = siluf_(ua0) * ub0; res[2 * j + 1] = siluf_(ua1) * ub1;
            }
            u32x4 w = {pk2(res[0], res[1]), pk2(res[2], res[3]), pk2(res[4], res[5]), pk2(res[6], res[7])};
            *(u32x4*)(ACT + (size_t)(r0 + rr + r) * DFF + col) = w;
            a2 = a1; a1 = a0; b2 = b1; b1 = b0;
        }
    }
}

struct Args { const float* in[19]; float* out; unsigned char* ws; };
#define CAS __attribute__((address_space(4)))
DI const CAS char* karg_() { const CAS char* ka = (const CAS char*)__builtin_amdgcn_kernarg_segment_ptr(); asm volatile("" : "+s"(ka)); return ka; }
#define INP(i) (*(const float* const CAS*)(karg_() + 8 * (i)))
#define OUTP() (*(float* const CAS*)(karg_() + 8 * 19))
#define WSP() (*(unsigned char* const CAS*)(karg_() + 8 * 20))

__global__ void __launch_bounds__(NT, 2) fwd_kernel(Args a) {
    extern __shared__ __attribute__((aligned(16))) unsigned char lds_raw[];
    LAS unsigned char* lds = (LAS unsigned char*)lds_raw;
    cg::grid_group grid = cg::this_grid();
    const int G = gridDim.x, bid = blockIdx.x;
    const int wv0 = __builtin_amdgcn_readfirstlane((int)threadIdx.x >> 6);
    const int NGW = G * 8;
    volatile LAS unsigned* xb_st = (volatile LAS unsigned*)(lds + LDS_BYTES - 16);
    if (threadIdx.x < 4) xb_st[threadIdx.x] = 0u;
    __syncthreads();
    const unsigned xb_x = xb_xcc_id();
    if (threadIdx.x == 0) (void)xb_add((unsigned*)WSP() + XB_XCNT(xb_x), 1u);
#define GBAR() grid_bar((unsigned*)WSP(), xb_st, xb_x, G, wv0)
#ifndef PROBE_PHASE
#define PROBE_PHASE -1
#endif
    unsigned long long pt0 = 0;
#define PB(n) do { if (PROBE_PHASE == (n)) pt0 = __builtin_amdgcn_s_memrealtime(); } while (0)
#define PE(n) do { if (PROBE_PHASE == (n)) { const unsigned long long t1 = __builtin_amdgcn_s_memrealtime(); const unsigned long long dt = t1 - pt0; while (__builtin_amdgcn_s_memrealtime() - t1 < dt) __builtin_amdgcn_s_sleep(8); } } while (0)
#define PHASE_IDS() const int tid = tid_(wv0), lane = tid & 63, wave = __builtin_amdgcn_readfirstlane(tid >> 6), gw = bid * 8 + wave; (void)lane; (void)gw; \
    unsigned char* ws = WSP(); const float* x = INP(0); float* out = OUTP(); (void)x; (void)out; LAS float* scr = (LAS float*)(lds + wave * 17408); (void)scr; \
    bf16_t* WIN_T = (bf16_t*)(ws + WS_WIN); bf16_t* WRET_T = (bf16_t*)(ws + WS_WRET); bf16_t* WNSA_T = (bf16_t*)(ws + WS_WNSA); bf16_t* WOUT_T = (bf16_t*)(ws + WS_WOUT); \
    bf16_t* XN = (bf16_t*)(ws + WS_XN); bf16_t* ARET = XN; bf16_t* PROJ = (bf16_t*)(ws + WS_PROJ); bf16_t* NSA = (bf16_t*)(ws + WS_NSA); \
    bf16_t* KT = (bf16_t*)(ws + WS_KT); bf16_t* VT = (bf16_t*)(ws + WS_VT); bf16_t* STATE = (bf16_t*)(ws + WS_STATE); bf16_t* MX = (bf16_t*)(ws + WS_MX); \
    float* ROTC = (float*)(ws + WS_ROTC); float* ROTS = (float*)(ws + WS_ROTS); \
    bf16_t* W1K_T = (bf16_t*)(ws + WS_W1K); bf16_t* W1V_T = (bf16_t*)(ws + WS_W1V); bf16_t* W2K_T = (bf16_t*)(ws + WS_W2K); bf16_t* W2V_T = (bf16_t*)(ws + WS_W2V); \
    float* KCMP = (float*)(ws + WS_KP); float* VCMPT = (float*)(ws + WS_VP); unsigned* SEL = (unsigned*)(ws + WS_SEL); \
    (void)W1K_T; (void)W1V_T; (void)W2K_T; (void)W2V_T; (void)KCMP; (void)VCMPT; (void)SEL; \
    bf16_t* WUP_T = (bf16_t*)(ws + WS_WUP); bf16_t* WDOWN_T = (bf16_t*)(ws + WS_WDOWN); bf16_t* XN2 = (bf16_t*)(ws + WS_XN2); bf16_t* U = (bf16_t*)(ws + WS_U); bf16_t* ACT = (bf16_t*)(ws + WS_ACT); \
    (void)WIN_T; (void)WRET_T; (void)WNSA_T; (void)WOUT_T; (void)XN; (void)ARET; (void)PROJ; (void)NSA; (void)KT; (void)VT; (void)STATE; (void)MX; (void)ROTC; (void)ROTS; (void)WUP_T; (void)WDOWN_T; (void)XN2; (void)U; (void)ACT;

#if STAGE >= 2
    PB(0);
    { PHASE_IDS();
        constexpr int I_IN = 32 * 220, I_SQ = 32 * 32;
        constexpr int I_W1 = 64 * 4, I_W2 = 4 * 2;
        constexpr int NIT = I_IN + 3 * I_SQ + 2 * I_W1 + 2 * I_W2;
        for (int it = gw; it < NIT; it += NGW) {
            int r = it;
            if (r >= I_IN + 3 * I_SQ) { r -= I_IN + 3 * I_SQ;
                if (r < I_W1) { transpose_item(INP(6), 4096, 256, W1K_T, scr, r, 4, lane); continue; } r -= I_W1;
                if (r < I_W1) { transpose_item(INP(9), 4096, 256, W1V_T, scr, r, 4, lane); continue; } r -= I_W1;
                if (r < I_W2) { transpose_item(INP(7), 256, 128, W2K_T, scr, r, 2, lane); continue; } r -= I_W2;
                transpose_item(INP(10), 256, 128, W2V_T, scr, r, 2, lane); continue; }
            if (r < I_IN) { transpose_item(INP(2), DM, NCOL, WIN_T, scr, r, 220, lane); continue; } r -= I_IN;
            if (r < I_SQ) { transpose_item(INP(4), DM, DM, WRET_T, scr, r, 32, lane); continue; } r -= I_SQ;
            if (r < I_SQ) { transpose_item(INP(11), DM, DM, WNSA_T, scr, r, 32, lane); continue; } r -= I_SQ;
            transpose_item(INP(12), DM, DM, WOUT_T, scr, r, 32, lane);
        }
        for (int i = bid * NT + tid; i < SEQ * 64; i += G * NT) {
            const int pos = i >> 6, f = i & 63;
            const float freq = exp2f(-(float)f * (13.287712379549449f / 64.f));
            const float ang = (float)pos * freq;
            ROTC[i] = cosf(ang); ROTS[i] = sinf(ang);
        }
        for (int m = gw; m < MH; m += NGW) rms_row_bf16(x + (size_t)m * DM, INP(1), XN + (size_t)m * DM, lane);
    }
    PE(0);
    grid.sync();
    { constexpr int hf = 0;
        const size_t grow0 = (size_t)hf * MH;
        { PHASE_IDS();
            pg8::Gemm g{XN, WIN_T, MH, LDP, DM}; pg8::StaticOrder S; S.init(MH, LDP, G, bid);
            pg8::Epi<0> E{PROJ, LDP, nullptr, 0, nullptr, 0, nullptr, nullptr};
            pg8::gemm_phase(lds, g, S, E, wv0);
        }
        GBAR();
        PB(2);
        { PHASE_IDS(); for (int ci = bid; ci < 16 * 32; ci += G) {
              const int it0 = (ci >> 5) * 64 + (ci & 31) * 2;
              rot_item(it0, PROJ, ROTC, ROTS, KT, VT, lds, wv0); rot_item(it0 + 1, PROJ, ROTC, ROTS, KT, VT, lds, wv0);
              asm volatile("s_waitcnt vmcnt(0)" ::: "memory"); __syncthreads();
              retA_item(ci, KT, VT, STATE, wv0); } }
#if STAGE >= 3
        { PHASE_IDS(); for (int it = G - 1 - bid; it < 256; it += G) cmp_item(it, hf, PROJ, INP(5), INP(8), W1K_T, W1V_T, W2K_T, W2V_T, KCMP, VCMPT, lds, wv0); }
#endif
        PE(2); GBAR(); PB(3);
        { PHASE_IDS(); for (int i = bid * NT + tid; i < 131072; i += G * NT) retB_scan(STATE, i, wv0); }
#if STAGE >= 3
        { PHASE_IDS(); for (int it = bid; it < 512; it += G) cattn_item(it, hf, PROJ, KCMP, VCMPT, out + grow0 * DM, SEL, lds, wv0); }
#endif
        PE(3); GBAR(); PB(4);
        { PHASE_IDS(); for (int it = bid; it < 16 * 32; it += G) retC_item(it, PROJ, VT, STATE, INP(3), ARET, lds, wv0); }
#if STAGE >= 3
        { PHASE_IDS(); att::phase(hf, PROJ, out + grow0 * DM, NSA, SEL, (char*)lds_raw, bid, G, wv0); }
#endif
        PE(4); GBAR();
#if STAGE >= 3
        { PHASE_IDS();
            pg8::Gemm g{ARET, WRET_T, MH, DM, DM, NSA, WNSA_T}; pg8::StaticOrder S; S.init(MH, DM, G, bid);
            pg8::Epi<6> E{MX, DM, PROJ + C_MG, LDP, nullptr, 0, nullptr, nullptr};
            pg8::gemm_phase<pg8::Epi<6>, true>(lds, g, S, E, wv0);
        }
#else
        { PHASE_IDS();
            pg8::Gemm g{ARET, WRET_T, MH, DM, DM}; pg8::StaticOrder S; S.init(MH, DM, G, bid);
            pg8::Epi<1> E{out + grow0 * DM, DM, PROJ + C_MG, LDP, nullptr, 0, nullptr, nullptr};
            pg8::gemm_phase(lds, g, S, E, wv0);
        }
        GBAR();
        { PHASE_IDS(); for (size_t i = (size_t)bid * NT + tid; i < (size_t)MH * DM / 4; i += (size_t)G * NT) {
            const f32x4 v = *((const f32x4*)(out + grow0 * DM) + i); u32x2 o = {pk2(v.x, v.y), pk2(v.z, v.w)}; *((u32x2*)MX + i) = o; } }
#endif
        GBAR();
        { PHASE_IDS();
            pg8::Gemm g{MX, WOUT_T, MH, DM, DM}; pg8::StaticOrder S; S.init(MH, DM, G, bid);
            pg8::Epi<3> E{out + grow0 * DM, DM, x + grow0 * DM, DM, nullptr, 0, nullptr, nullptr};
            pg8::gemm_phase(lds, g, S, E, wv0);
        }
        if (hf == 0) { PHASE_IDS(); for (int m = gw; m < MH; m += NGW) rms_row_bf16(x + (size_t)(MH + m) * DM, INP(1), XN + (size_t)m * DM, lane); }
        GBAR();
    }
    { constexpr int hf = 1;
        const size_t grow0 = (size_t)hf * MH;
        { PHASE_IDS();
            pg8::Gemm g{XN, WIN_T, MH, LDP, DM}; pg8::StaticOrder S; S.init(MH, LDP, G, bid);
            pg8::Epi<0> E{PROJ, LDP, nullptr, 0, nullptr, 0, nullptr, nullptr};
            pg8::gemm_phase(lds, g, S, E, wv0);
        }
        GBAR();
        PB(2);
        { PHASE_IDS(); for (int ci = bid; ci < 16 * 32; ci += G) {
              const int it0 = (ci >> 5) * 64 + (ci & 31) * 2;
              rot_item(it0, PROJ, ROTC, ROTS, KT, VT, lds, wv0); rot_item(it0 + 1, PROJ, ROTC, ROTS, KT, VT, lds, wv0);
              asm volatile("s_waitcnt vmcnt(0)" ::: "memory"); __syncthreads();
              retA_item(ci, KT, VT, STATE, wv0); } }
#if STAGE >= 3
        { PHASE_IDS(); for (int it = G - 1 - bid; it < 256; it += G) cmp_item(it, hf, PROJ, INP(5), INP(8), W1K_T, W1V_T, W2K_T, W2V_T, KCMP, VCMPT, lds, wv0); }
#endif
        PE(2); GBAR(); PB(3);
        { PHASE_IDS(); for (int i = bid * NT + tid; i < 131072; i += G * NT) retB_scan(STATE, i, wv0); }
#if STAGE >= 3
        { PHASE_IDS(); for (int it = bid; it < 512; it += G) cattn_item(it, hf, PROJ, KCMP, VCMPT, out + grow0 * DM, SEL, lds, wv0); }
#endif
        PE(3); GBAR(); PB(4);
        { PHASE_IDS(); for (int it = bid; it < 16 * 32; it += G) retC_item(it, PROJ, VT, STATE, INP(3), ARET, lds, wv0); }
#if STAGE >= 3
        { PHASE_IDS(); att::phase(hf, PROJ, out + grow0 * DM, NSA, SEL, (char*)lds_raw, bid, G, wv0); }
#endif
        PE(4); GBAR();
#if STAGE >= 3
        { PHASE_IDS();
            pg8::Gemm g{ARET, WRET_T, MH, DM, DM, NSA, WNSA_T}; pg8::StaticOrder S; S.init(MH, DM, G, bid);
            pg8::Epi<6> E{MX, DM, PROJ + C_MG, LDP, nullptr, 0, nullptr, nullptr};
            pg8::gemm_phase<pg8::Epi<6>, true>(lds, g, S, E, wv0);
        }
#else
        { PHASE_IDS();
            pg8::Gemm g{ARET, WRET_T, MH, DM, DM}; pg8::StaticOrder S; S.init(MH, DM, G, bid);
            pg8::Epi<1> E{out + grow0 * DM, DM, PROJ + C_MG, LDP, nullptr, 0, nullptr, nullptr};
            pg8::gemm_phase(lds, g, S, E, wv0);
        }
        GBAR();
        { PHASE_IDS(); for (size_t i = (size_t)bid * NT + tid; i < (size_t)MH * DM / 4; i += (size_t)G * NT) {
            const f32x4 v = *((const f32x4*)(out + grow0 * DM) + i); u32x2 o = {pk2(v.x, v.y), pk2(v.z, v.w)}; *((u32x2*)MX + i) = o; } }
#endif
        GBAR();
        { PHASE_IDS();
            pg8::Gemm g{MX, WOUT_T, MH, DM, DM}; pg8::StaticOrder S; S.init(MH, DM, G, bid);
            pg8::Epi<3> E{out + grow0 * DM, DM, x + grow0 * DM, DM, nullptr, 0, nullptr, nullptr};
            pg8::gemm_phase(lds, g, S, E, wv0);
        }
        if (hf == 0) { PHASE_IDS(); for (int m = gw; m < MH; m += NGW) rms_row_bf16(x + (size_t)(MH + m) * DM, INP(1), XN + (size_t)m * DM, lane); }
        GBAR();
    }
#else
    { PHASE_IDS(); for (size_t i = (size_t)bid * NT + tid; i < (size_t)MTOK * DM / 4; i += (size_t)G * NT) ((f32x4*)out)[i] = ((const f32x4*)x)[i]; }
    GBAR();
#endif
    PB(8);
    { PHASE_IDS();
        constexpr int I_UP = 32 * 176, I_DN = 88 * 32;
        for (int it = gw; it < I_UP + I_DN; it += NGW) {
            if (it < I_UP) transpose_item<true>(INP(14), DM, DFF2, WUP_T, scr, it, 176, lane);
            else transpose_item(INP(17), DFF, DM, WDOWN_T, scr, it - I_UP, 32, lane);
        }
        for (int m = gw; m < MTOK; m += NGW) rms_row_bf16(out + (size_t)m * DM, INP(13), XN2 + (size_t)m * DM, lane);
    }
    PE(8); GBAR();
    { PHASE_IDS();
        pg8::Gemm g{XN2, WUP_T, MTOK, DFF2, DM}; pg8::StaticOrder S; S.init(MTOK, DFF2, G, bid);
        pg8::Epi<5> E{ACT, DFF, INP(15), 0, INP(16), 0, (float*)(ws + WS_UB), (float*)(ws + WS_PB)};
        pg8::gemm_phase(lds, g, S, E, wv0);
    }
    GBAR();
    { PHASE_IDS();
        const float* cw = INP(15); const float* UB = (const float*)(ws + WS_UB); const float* PB = (const float*)(ws + WS_PB);
        for (int idx = bid * NT + tid; idx < 256 * 2 * (DFF / 4); idx += G * NT) {
            const int sidx = idx / (2 * (DFF / 4)), rem = idx % (2 * (DFF / 4)), q = rem / (DFF / 4), c4 = (rem % (DFF / 4)) * 4;
            const int row = 64 * sidx + q;
            const float* pp = PB + (size_t)(2 * sidx + q) * DFF2 + c4;
            f32x4 pa = *(const f32x4*)pp, pb = *(const f32x4*)(pp + DFF);
            if ((row & (SEQ - 1)) >= 2) {
                const float* u62 = UB + (size_t)(2 * (sidx - 1)) * DFF2 + c4; const float* u63 = u62 + DFF2;
                const f32x4 wa0 = *(const f32x4*)(cw + c4), wa1 = *(const f32x4*)(cw + DFF2 + c4), wb0 = *(const f32x4*)(cw + DFF + c4), wb1 = *(const f32x4*)(cw + DFF2 + DFF + c4);
                if (q == 0) { pa = pa + wa1 * *(const f32x4*)u63 + wa0 * *(const f32x4*)u62; pb = pb + wb1 * *(const f32x4*)(u63 + DFF) + wb0 * *(const f32x4*)(u62 + DFF); }
                else { pa = pa + wa0 * *(const f32x4*)u63; pb = pb + wb0 * *(const f32x4*)(u63 + DFF); }
            }
            u32x2 w = {pk2(siluf_(pa[0]) * pb[0], siluf_(pa[1]) * pb[1]), pk2(siluf_(pa[2]) * pb[2], siluf_(pa[3]) * pb[3])};
            *(u32x2*)(ACT + (size_t)row * DFF + c4) = w;
        }
    }
    GBAR();
    { PHASE_IDS();
        pg8::Gemm g{ACT, WDOWN_T, MTOK, DM, DFF}; pg8::StaticOrder S; S.init(MTOK, DM, G, bid);
        pg8::Epi<4> E{out, DM, nullptr, 0, nullptr, 0, nullptr, nullptr};
        pg8::gemm_phase(lds, g, S, E, wv0);
    }
    GBAR();
    PB(12);
    { PHASE_IDS(); for (int m = gw; m < MTOK; m += NGW) rms_row_f32(out + (size_t)m * DM, INP(18), lane); }
    PE(12);
}

extern "C" void kernel_launch(void* const* d_in, const int* in_sizes, int n_in, void* d_out, int out_size, void* d_ws, size_t ws_size, hipStream_t stream) {
    static int grid = 0;
    if (grid == 0) {
        if (n_in != 19 || out_size != MTOK * DM || ws_size < WS_END) { fprintf(stderr, "kernel_launch: unexpected shapes (n_in %d out %d ws %zu)\n", n_in, out_size, ws_size); grid = -1; return; }
        int dev = 0, cus = 0, per_cu = 0;
        (void)hipGetDevice(&dev); (void)hipDeviceGetAttribute(&cus, hipDeviceAttributeMultiprocessorCount, dev);
        if (hipFuncSetAttribute((const void*)fwd_kernel, hipFuncAttributeMaxDynamicSharedMemorySize, LDS_BYTES) != hipSuccess) { fprintf(stderr, "hipFuncSetAttribute failed\n"); grid = -1; return; }
        if (hipOccupancyMaxActiveBlocksPerMultiprocessor(&per_cu, (const void*)fwd_kernel, NT, LDS_BYTES) != hipSuccess || per_cu < 1) { fprintf(stderr, "occupancy query: %d\n", per_cu); per_cu = 1; }
        (void)hipGetLastError();
        grid = cus > 0 ? cus : 256;
    }
    if (grid < 0) return;
    Args a{};
    for (int i = 0; i < 19; ++i) a.in[i] = (const float*)d_in[i];
    a.out = (float*)d_out; a.ws = (unsigned char*)d_ws;
    (void)hipMemsetAsync(d_ws, 0, XCD_BAR_WORDS * 4, stream);
    void* args[] = {&a};
    hipError_t e = hipLaunchCooperativeKernel((const void*)fwd_kernel, dim3(grid), dim3(NT), args, LDS_BYTES, stream);
    if (e != hipSuccess) fprintf(stderr, "cooperative launch failed: %s (grid %d)\n", hipGetErrorString(e), grid);
}
```

```cpp
#include <hip/hip_runtime.h>
#include <hip/hip_cooperative_groups.h>
#include <cstdio>
#include <cstdint>
namespace cg = cooperative_groups;

#ifndef STAGE
#define STAGE 3
#endif

#define LAS __attribute__((address_space(3)))
typedef unsigned short bf16_t;
typedef short bf16x8 __attribute__((ext_vector_type(8)));
typedef short s16x4 __attribute__((ext_vector_type(4)));
typedef float f32x4 __attribute__((ext_vector_type(4)));
typedef float f32x16 __attribute__((ext_vector_type(16)));
typedef unsigned u32x4 __attribute__((ext_vector_type(4)));
typedef unsigned u32x2 __attribute__((ext_vector_type(2)));
typedef __bf16 bf16v2 __attribute__((ext_vector_type(2)));
typedef float f32v2 __attribute__((ext_vector_type(2)));
#define DI __device__ __forceinline__
#define LDS_WAIT() asm volatile("s_waitcnt lgkmcnt(0)" ::: "memory")
#define MFMA32(a, b, c) __builtin_amdgcn_mfma_f32_32x32x16_bf16((a), (b), (c), 0, 0, 0)
#define MFMA16(a, b, c) __builtin_amdgcn_mfma_f32_16x16x32_bf16((a), (b), (c), 0, 0, 0)

constexpr int DM = 2048, SEQ = 4096, MTOK = 16384, MH = 8192;
constexpr int NCOL = 13872, LDP = 14080;
constexpr int C_RQ = 0, C_RK = 1024, C_RV = 2048, C_RG = 4096, C_NQ = 6144, C_KC = 8192, C_VC = 8448, C_KS = 8704, C_VS = 8960,
              C_KW = 9216, C_VW = 9472, C_NG = 9728, C_MG = 9776;
constexpr int DFF = 5632, DFF2 = 11264;
constexpr float EPS = 1e-6f;
constexpr size_t MiB = 1u << 20;
constexpr size_t WS_WIN = 1 * MiB, WS_WRET = 56 * MiB, WS_WNSA = 64 * MiB, WS_WOUT = 72 * MiB, WS_W1K = 80 * MiB, WS_W1V = 82 * MiB,
                 WS_W2K = 84 * MiB, WS_W2V = 84 * MiB + 65536, WS_ROTC = 85 * MiB, WS_ROTS = 86 * MiB, WS_KCMP = 87 * MiB, WS_VCMPT = 87 * MiB + 524288,
                 WS_SEL = 88 * MiB, WS_XN = 90 * MiB  , WS_PROJ = 122 * MiB, WS_NSA = 342 * MiB, WS_KT = 374 * MiB, WS_VT = 390 * MiB,
                 WS_STATE = 422 * MiB, WS_MX = 374 * MiB  ,
                 WS_WUP = 90 * MiB, WS_WDOWN = 134 * MiB, WS_XN2 = 156 * MiB, WS_U = 220 * MiB, WS_ACT = 220 * MiB, WS_UB = 396 * MiB, WS_PB = 420 * MiB, WS_KP = 454 * MiB, WS_VP = 456 * MiB, WS_END = 484 * MiB;
constexpr int LDS_BYTES = 143360;
constexpr int NT = 512;

DI unsigned pk2(float lo, float hi) { f32v2 v = {lo, hi}; bf16v2 b = __builtin_convertvector(v, bf16v2); return __builtin_bit_cast(unsigned, b); }
DI float bf2f(unsigned short b) { return __uint_as_float(((unsigned)b) << 16); }
DI float bflo(unsigned w) { return __uint_as_float(w << 16); }
DI float bfhi(unsigned w) { return __uint_as_float(w & 0xffff0000u); }
DI bf16x8 pack8(f32x4 a, f32x4 b) { u32x4 w = {pk2(a[0], a[1]), pk2(a[2], a[3]), pk2(b[0], b[1]), pk2(b[2], b[3])}; return __builtin_bit_cast(bf16x8, w); }
DI float sigmoidf_(float x) { return __builtin_amdgcn_rcpf(1.f + __builtin_amdgcn_exp2f(-1.4426950408889634f * x)); }
DI float siluf_(float x) { return x * __builtin_amdgcn_rcpf(1.f + __builtin_amdgcn_exp2f(-1.4426950408889634f * x)); }
template <int M> DI float swz(float v) { return __int_as_float(__builtin_amdgcn_ds_swizzle(__float_as_int(v), (M << 10) | 0x1F)); }
template <int M> DI unsigned swzu(unsigned v) { return (unsigned)__builtin_amdgcn_ds_swizzle((int)v, (M << 10) | 0x1F); }
DI float xor32(float v, int hi) { auto rr = __builtin_amdgcn_permlane32_swap(__float_as_uint(v), __float_as_uint(v), false, false); return __uint_as_float(hi ? rr[0] : rr[1]); }
DI float sum32(float v) { auto rr = __builtin_amdgcn_permlane32_swap(__float_as_uint(v), __float_as_uint(v), false, false); return __uint_as_float(rr[0]) + __uint_as_float(rr[1]); }
DI float wave_sum(float v) { v += swz<1>(v); v += swz<2>(v); v += swz<4>(v); v += swz<8>(v); v += swz<16>(v); return sum32(v); }
DI int tid_(int wv) { int t; asm volatile("v_mbcnt_lo_u32_b32 %0, -1, 0\n\tv_mbcnt_hi_u32_b32 %0, -1, %0" : "=v"(t)); return (wv << 6) | t; }
#define XB_TMO      128
#define XB_XCNT(j)  (256  + 64 * (j))
#define XB_XSUB(j)  (1280 + 64 * (j))
#define XB_XGEN(j)  (2304 + 64 * (j))
#define XB_TOP      3328
#define XB_TOPGEN   3392
#define XCD_BAR_WORDS 3456
#define XB_SPIN_CAP (1u << 20)
DI unsigned xb_ld(unsigned* p)              { return __hip_atomic_load(p, __ATOMIC_RELAXED, __HIP_MEMORY_SCOPE_AGENT); }
DI unsigned xb_add(unsigned* p, unsigned v) { return __hip_atomic_fetch_add(p, v, __ATOMIC_RELAXED, __HIP_MEMORY_SCOPE_AGENT); }
DI unsigned xb_xcc_id() { return (unsigned)__builtin_amdgcn_s_getreg((3 << 11) | 20) & 0xFu; }
#define XB_SPIN(cond, bar) do { unsigned _sp = 0; while (cond) { __builtin_amdgcn_s_sleep(1); \
    if ((++_sp & 255u) == 0u) { if (xb_ld(&(bar)[XB_TMO])) break; if (_sp > XB_SPIN_CAP) { atomicAdd(&(bar)[XB_TMO], 1u); break; } } } } while (0)
DI void xcd_barrier_complete(unsigned* bar, unsigned x, unsigned G, unsigned& nloc, unsigned& nx) {
    unsigned sum, cnt, mine, sp = 0u;
    for (;;) {
        sum = 0u; cnt = 0u; mine = 0u;
#pragma unroll
        for (unsigned j = 0; j < 16; ++j) { const unsigned c = xb_ld(&bar[XB_XCNT(j)]); sum += c; cnt += (c > 0u) ? 1u : 0u; mine = (j == x) ? c : mine; }
        if (sum == G) break;
        __builtin_amdgcn_s_sleep(1);
        if ((++sp & 255u) == 0u) { if (xb_ld(&bar[XB_TMO])) break; if (sp > XB_SPIN_CAP) { atomicAdd(&bar[XB_TMO], 1u); break; } }
    }
    nloc = mine > 0u ? mine : 1u; nx = cnt > 0u ? cnt : 1u;
}
DI void grid_bar(unsigned* bar, volatile LAS unsigned* st, unsigned x, int G, int wv) {
    asm volatile("s_waitcnt vmcnt(0)" ::: "memory");
    __syncthreads();
    const int t = tid_(wv);
    if (t == 0) {
        __builtin_amdgcn_s_waitcnt(0);
        unsigned nloc = st[0], nx = st[1];
        if (nloc == 0u) { xcd_barrier_complete(bar, x, (unsigned)G, nloc, nx); st[0] = nloc; st[1] = nx; }
        const unsigned old = xb_add(&bar[XB_XSUB(x)], 1u);
        const unsigned gen = old / nloc;
        if (old + 1u == (gen + 1u) * nloc) {
            __builtin_amdgcn_fence(__ATOMIC_RELEASE, "agent");
            asm volatile("s_waitcnt vmcnt(0)" ::: "memory");
            const unsigned og = xb_add(&bar[XB_TOP], 1u);
            const unsigned tg = og / nx;
            if (og + 1u == (tg + 1u) * nx) xb_add(&bar[XB_TOPGEN], 1u);
            else XB_SPIN(xb_ld(&bar[XB_TOPGEN]) == tg, bar);
            __builtin_amdgcn_fence(__ATOMIC_ACQUIRE, "agent");
            xb_add(&bar[XB_XGEN(x)], 1u);
            asm volatile("s_waitcnt vmcnt(0)" ::: "memory");
        } else {
            XB_SPIN(xb_ld(&bar[XB_XGEN(x)]) == gen, bar);
            __builtin_amdgcn_fence(__ATOMIC_ACQUIRE, "agent");
            asm volatile("s_waitcnt vmcnt(0)" ::: "memory");
        }
    }
    __syncthreads();
}
DI int zero_() { int z = 0; asm volatile("" : "+s"(z)); return z; }
template <class T> DI T* lnd(T* p) { return p + zero_(); }
DI int crow(int r, int hi) { return (r & 3) + 8 * (r >> 2) + 4 * hi; }
DI float log2gamma(int h) { return log2f(1.0f - exp2f(-5.0f - (float)h)); }

namespace pg8 {
constexpr int BM = 256, BK = 64, HALF = 128, HTB = HALF * BK * 2, STAGE_BYTES = 8 * HTB, NXCD = 8, WGM = 8;
DI int lds_byte(int r, int c) { const int st = (r >> 4) * 2 + (c >> 5), rr = r & 15, cc = c & 31, ob = rr * 64 + cc * 2; return st * 1024 + (ob ^ (((ob >> 9) & 1) << 5)); }
DI void stage_rc(int b, int& R, int& C) { const int st = b / 1024, sb = b % 1024, swz = sb ^ (((sb >> 9) & 1) << 5); R = (st >> 1) * 16 + swz / 64; C = (st & 1) * 32 + (swz % 64) / 2; }
DI int perm32(int rho) { const int n = rho >> 4, i = rho & 15; return 8 * (i >> 2) + 4 * n + (i & 3); }
struct Unit { int pm, pn; };
struct Gemm { const bf16_t* A; const bf16_t* Bt; int M, N, K; const bf16_t* A2; const bf16_t* Bt2; };
struct StaticOrder {
    int nM, nN, nwg, G, c;
    DI void init(int M, int N, int G_, int c_) { nM = M / BM; nN = N / BM; nwg = nM * nN; G = G_; c = c_; }
    DI bool next(int i, Unit& u) const {
        const long L = (long)i * G + c; if (L >= nwg) return false;
        int wgid = (int)L; { const int q = nwg / NXCD, r = nwg % NXCD, xcd = wgid % NXCD, off = wgid / NXCD; wgid = (xcd < r ? xcd * (q + 1) : r * (q + 1) + (xcd - r) * q) + off; }
        const int nig = WGM * nN, gid = wgid / nig, fm = gid * WGM, gsz = (nM - fm) < WGM ? (nM - fm) : WGM;
        u.pm = fm + ((wgid % nig) % gsz); u.pn = (wgid % nig) / gsz; return true;
    }
};
template <int MODE> struct Epi {
    void* out; int ldo; const void* aux; int ldaux; const void* aux2; int ldaux2; float* ex1; float* ex2;
    static DI float ror1(float v) { return __int_as_float(__builtin_amdgcn_update_dpp(0, __float_as_int(v), 0x121, 0xf, 0xf, false)); }
    static DI float ror2(float v) { return __int_as_float(__builtin_amdgcn_update_dpp(0, __float_as_int(v), 0x122, 0xf, 0xf, false)); }
    DI void conv_epi(const f32x4 (&acc)[2][2][4][2], const Unit& u, int wr, int wc, int fr, int fq) const {
        const float* cw = (const float*)aux; const float* cb = (const float*)aux2;
        const bool l15 = fr == 15, l14 = fr >= 14;
#pragma unroll
        for (int n = 0; n < 2; ++n) {
            const int col = u.pn * 128 + wc * 32 + 8 * fq + 4 * n;
            const f32x4 wa0 = *(const f32x4*)(cw + col), wa1 = *(const f32x4*)(cw + DFF2 + col), wa2 = *(const f32x4*)(cw + 2 * DFF2 + col), ba = *(const f32x4*)(cb + col);
            const f32x4 wb0 = *(const f32x4*)(cw + DFF + col), wb1 = *(const f32x4*)(cw + DFF2 + DFF + col), wb2 = *(const f32x4*)(cw + 2 * DFF2 + DFF + col), bb = *(const f32x4*)(cb + DFF + col);
#pragma unroll
            for (int ai = 0; ai < 2; ++ai) {
                const int strip = u.pm * 4 + ai * 2 + wr;
                f32x4 ca[4], cbv[4];
#pragma unroll
                for (int m = 0; m < 4; ++m) {
                    const f32x4 va = acc[ai][0][m][n], vb = acc[ai][1][m][n];
                    f32x4 pa1, pa2, pb1, pb2;
#pragma unroll
                    for (int j = 0; j < 4; ++j) {
                        const float am1 = m > 0 ? acc[ai][0][m > 0 ? m - 1 : 0][n][j] : 0.f, bm1 = m > 0 ? acc[ai][1][m > 0 ? m - 1 : 0][n][j] : 0.f;
                        pa1[j] = ror1(l15 ? am1 : va[j]); pa2[j] = ror2(l14 ? am1 : va[j]);
                        pb1[j] = ror1(l15 ? bm1 : vb[j]); pb2[j] = ror2(l14 ? bm1 : vb[j]);
                    }
                    ca[m] = wa0 * pa2 + wa1 * pa1 + wa2 * va + ba;
                    cbv[m] = wb0 * pb2 + wb1 * pb1 + wb2 * vb + bb;
                }
#pragma unroll
                for (int m = 0; m < 4; ++m) {
                    const size_t row = (size_t)(u.pm * BM + ai * HALF + wr * 64 + m * 16 + fr);
                    if (m == 0 && fr < 2) {
                        float* p = ex2 + (size_t)(strip * 2 + fr) * DFF2 + col; *(f32x4*)p = ca[0]; *(f32x4*)(p + DFF) = cbv[0];
                    } else {
                        const f32x4 a = ca[m], b = cbv[m];
                        u32x2 w = {pk2(siluf_(a[0]) * b[0], siluf_(a[1]) * b[1]), pk2(siluf_(a[2]) * b[2], siluf_(a[3]) * b[3])};
                        *(u32x2*)((bf16_t*)out + row * ldo + col) = w;
                    }
                }
                if (fr >= 14) { float* p = ex1 + (size_t)(strip * 2 + (fr - 14)) * DFF2 + col; *(f32x4*)p = acc[ai][0][3][n]; *(f32x4*)(p + DFF) = acc[ai][1][3][n]; }
            }
        }
    }
    DI void scale(f32x4 (&acc)[2][2][4][2], const Unit& u, int wr, int wc, int fr, int fq, int part) const {
        const float keep = part == 0 ? 1.f : 0.f;
#pragma unroll
        for (int ai = 0; ai < 2; ++ai)
#pragma unroll
            for (int m = 0; m < 4; ++m) {
                int rowi = u.pm * BM + wr * 64 + fr + ai * HALF + m * 16; asm volatile("" : "+v"(rowi));
                const bf16_t* gp0 = (const bf16_t*)aux + (size_t)rowi * ldaux + u.pn * BM + wc * 32 + 8 * fq;
#pragma unroll
                for (int bj = 0; bj < 2; ++bj) {
                    const u32x4 gr = *(const u32x4*)(gp0 + bj * HALF), gn = *(const u32x4*)(gp0 + bj * HALF + 2048);
#pragma unroll
                    for (int q = 0; q < 4; ++q) {
                        const float r0 = keep * sigmoidf_(bflo(gr[q])) * (1.f + __builtin_amdgcn_exp2f(fminf(-1.4426950408889634f * bflo(gn[q]), 60.f)));
                        const float r1 = keep * sigmoidf_(bfhi(gr[q])) * (1.f + __builtin_amdgcn_exp2f(fminf(-1.4426950408889634f * bfhi(gn[q]), 60.f)));
                        acc[ai][bj][m][q >> 1][(q & 1) * 2] *= r0; acc[ai][bj][m][q >> 1][(q & 1) * 2 + 1] *= r1;
                    }
                }
                asm volatile("" ::: "memory");
            }
    }
    DI void fin6(const f32x4 (&acc)[2][2][4][2], const Unit& u, int wr, int wc, int fr, int fq) const {
#pragma unroll
        for (int ai = 0; ai < 2; ++ai)
#pragma unroll
            for (int m = 0; m < 4; ++m) {
                int rowi = u.pm * BM + wr * 64 + fr + ai * HALF + m * 16; asm volatile("" : "+v"(rowi));
                const int colb = u.pn * BM + wc * 32 + 8 * fq;
                const bf16_t* gp0 = (const bf16_t*)aux + (size_t)rowi * ldaux + colb + 2048;
#pragma unroll
                for (int bj = 0; bj < 2; ++bj) {
                    const u32x4 g = *(const u32x4*)(gp0 + bj * HALF);
                    const f32x4 v0 = acc[ai][bj][m][0], v1 = acc[ai][bj][m][1];
                    u32x4 w = {pk2(v0[0] * sigmoidf_(bflo(g[0])), v0[1] * sigmoidf_(bfhi(g[0]))), pk2(v0[2] * sigmoidf_(bflo(g[1])), v0[3] * sigmoidf_(bfhi(g[1]))),
                               pk2(v1[0] * sigmoidf_(bflo(g[2])), v1[1] * sigmoidf_(bfhi(g[2]))), pk2(v1[2] * sigmoidf_(bflo(g[3])), v1[3] * sigmoidf_(bfhi(g[3])))};
                    *(u32x4*)((bf16_t*)out + (size_t)rowi * ldo + colb + bj * HALF) = w;
                }
                asm volatile("" ::: "memory");
            }
    }
    DI void operator()(const f32x4 (&acc)[2][2][4][2], const Unit& u, int wr, int wc, int fr, int fq) const {
        if constexpr (MODE == 5) { conv_epi(acc, u, wr, wc, fr, fq); return; }
        if constexpr (MODE == 6) { fin6(acc, u, wr, wc, fr, fq); return; }
        const int row0 = u.pm * BM + wr * 64 + fr, col0 = u.pn * BM + wc * 32 + 8 * fq;
#pragma unroll
        for (int ai = 0; ai < 2; ++ai)
#pragma unroll
            for (int m = 0; m < 4; ++m) {
                const size_t row = (size_t)(row0 + ai * HALF + m * 16);
#pragma unroll
                for (int bj = 0; bj < 2; ++bj) {
                    const int col = col0 + bj * HALF;
                    f32x4 v0 = acc[ai][bj][m][0], v1 = acc[ai][bj][m][1];
                    if constexpr (MODE == 0) {
                        u32x4 w = {pk2(v0[0], v0[1]), pk2(v0[2], v0[3]), pk2(v1[0], v1[1]), pk2(v1[2], v1[3])};
                        *(u32x4*)((bf16_t*)out + row * ldo + col) = w;
                    } else if constexpr (MODE == 1 || MODE == 2) {
                        const u32x4 g = *(const u32x4*)((const bf16_t*)aux + row * ldaux + col);
                        f32x4 g0 = {sigmoidf_(bflo(g[0])), sigmoidf_(bfhi(g[0])), sigmoidf_(bflo(g[1])), sigmoidf_(bfhi(g[1]))};
                        f32x4 g1 = {sigmoidf_(bflo(g[2])), sigmoidf_(bfhi(g[2])), sigmoidf_(bflo(g[3])), sigmoidf_(bfhi(g[3]))};
                        v0 = v0 * g0; v1 = v1 * g1;
                        if constexpr (MODE == 1) { float* o = (float*)out + row * ldo + col; *(f32x4*)o = v0; *(f32x4*)(o + 4) = v1; }
                        else { const float* t = (const float*)aux2 + row * ldaux2 + col; v0 = v0 + *(const f32x4*)t; v1 = v1 + *(const f32x4*)(t + 4);
                            u32x4 w = {pk2(v0[0], v0[1]), pk2(v0[2], v0[3]), pk2(v1[0], v1[1]), pk2(v1[2], v1[3])};
                            *(u32x4*)((bf16_t*)out + row * ldo + col) = w; }
                    } else if constexpr (MODE == 3) {
                        const float* x = (const float*)aux + row * ldaux + col; float* o = (float*)out + row * ldo + col;
                        *(f32x4*)o = v0 + *(const f32x4*)x; *(f32x4*)(o + 4) = v1 + *(const f32x4*)(x + 4);
                    } else {
                        float* o = (float*)out + row * ldo + col;
                        *(f32x4*)o = v0 + *(const f32x4*)o; *(f32x4*)(o + 4) = v1 + *(const f32x4*)(o + 4);
                    }
                }
            }
    }
};

template <class EpiT, bool DUAL = false>
DI void gemm_phase(LAS unsigned char* lds, const Gemm g, const StaticOrder& S, const EpiT& E, int wv) {
    const int tid = tid_(wv), wid = __builtin_amdgcn_readfirstlane(tid >> 6), lane = tid & 63, wr = wid >> 2, wc = wid & 3, fr = lane & 15, fq = lane >> 4;
    int K = g.K; const char* gA = (const char*)g.A; const char* gB = (const char*)g.Bt;
    const char* gA2 = DUAL ? (const char*)g.A2 : gA; const char* gB2 = DUAL ? (const char*)g.Bt2 : gB;
    asm volatile("" : "+s"(K), "+s"(gA), "+s"(gB), "+s"(gA2), "+s"(gB2));
    const int nt = K / BK;
    unsigned voffA[2], voffB[2];
#pragma unroll
    for (int i = 0; i < 2; ++i) { int R, C; stage_rc(tid * 16 + i * 8192, R, C); const int Rb = (R & ~31) + perm32(R & 31);
        voffA[i] = (unsigned)(R * K + C) * 2u; voffB[i] = (unsigned)(Rb * K + C) * 2u; }
    const size_t kstep = (size_t)(BK * 2);
    const size_t hstep = (size_t)HALF * K * 2;
    const size_t tstep = 2 * hstep;
    const unsigned ldsw = (unsigned)wid * 1024u;
    const int aoff = lds_byte(wr * 64 + fr, fq * 8), boff = lds_byte(wc * 32 + fr, fq * 8);
#define PG8_SA(b, h) (((b) * 2 + (h)) * HTB)
#define PG8_SB(b, h) ((4 + (b) * 2 + (h)) * HTB)
#define PG8_STAGE(bufoff, gbase, voff) do { _Pragma("unroll") for (int _i = 0; _i < 2; ++_i) \
        __builtin_amdgcn_global_load_lds((const unsigned*)((const char*)(gbase) + (voff)[_i]), (LAS unsigned*)(lds + (bufoff) + ldsw + _i * 8192), 16, 0, 0); } while (0)
#define PG8_LDA(dst, b, h) do { _Pragma("unroll") for (int m = 0; m < 4; ++m) _Pragma("unroll") for (int k = 0; k < 2; ++k) dst[m][k] = *(const LAS bf16x8*)(lds + PG8_SA(b, h) + aoff + m * 2048 + k * 1024); } while (0)
#define PG8_LDB(dst, b, h) do { _Pragma("unroll") for (int n = 0; n < 2; ++n) _Pragma("unroll") for (int k = 0; k < 2; ++k) dst[n][k] = *(const LAS bf16x8*)(lds + PG8_SB(b, h) + boff + n * 2048 + k * 1024); } while (0)
#define PG8_MMA(ai, bj, At, Bt) do { __builtin_amdgcn_s_setprio(1); _Pragma("unroll") for (int m = 0; m < 4; ++m) _Pragma("unroll") for (int n = 0; n < 2; ++n) _Pragma("unroll") for (int k = 0; k < 2; ++k) \
        acc[ai][bj][m][n] = __builtin_amdgcn_mfma_f32_16x16x32_bf16(Bt[n][k], At[m][k], acc[ai][bj][m][n], 0, 0, 0); __builtin_amdgcn_s_setprio(0); } while (0)
#define PG8_WAIT_V(n) asm volatile("s_waitcnt vmcnt(" #n ")" ::: "memory")
#define PG8_WAIT_L(n) asm volatile("s_waitcnt lgkmcnt(" #n ")" ::: "memory")
#define PG8_BAR __builtin_amdgcn_s_barrier()
#define PG8_SCHED __builtin_amdgcn_sched_barrier(0)
    Unit cur, nxt; int ui = 0; int part = 0; (void)part;
    if (!S.next(0, cur)) return;
    f32x4 acc[2][2][4][2];
#pragma unroll
    for (int a = 0; a < 2; ++a)
#pragma unroll
        for (int b = 0; b < 2; ++b)
#pragma unroll
            for (int m = 0; m < 4; ++m)
#pragma unroll
                for (int n = 0; n < 2; ++n) acc[a][b][m][n] = (f32x4){0.f, 0.f, 0.f, 0.f};
    bf16x8 At[4][2], B0[2][2], B1[2][2];
    const char* cA = gA + (size_t)cur.pm * tstep; const char* cB = gB + (size_t)cur.pn * tstep;
    PG8_STAGE(PG8_SB(0, 0), cB, voffB); PG8_STAGE(PG8_SA(0, 0), cA, voffA); PG8_STAGE(PG8_SB(0, 1), cB + hstep, voffB); PG8_STAGE(PG8_SA(0, 1), cA + hstep, voffA);
    if (wr == 1) PG8_BAR;
    PG8_WAIT_V(4); PG8_BAR;
    PG8_STAGE(PG8_SB(1, 0), cB + kstep, voffB); PG8_STAGE(PG8_SA(1, 0), cA + kstep, voffA); PG8_STAGE(PG8_SB(1, 1), cB + hstep + kstep, voffB);
    PG8_WAIT_V(6); PG8_BAR;
    for (;;) {
        bool has_next; int npart = 0;
        if (DUAL && part == 0) { nxt = cur; npart = 1; has_next = true; }
        else has_next = S.next(ui + 1, nxt);
        const char* nA = has_next ? (npart ? gA2 : gA) + (size_t)nxt.pm * tstep : cA; const char* nB = has_next ? (npart ? gB2 : gB) + (size_t)nxt.pn * tstep : cB;
        for (int t = 0; t < nt; t += 2) {
            const bool last = (t == nt - 2);
            const char* a1 = cA + (size_t)(t + 1) * kstep;
            const char* a2 = last ? nA : cA + (size_t)(t + 2) * kstep; const char* b2 = last ? nB : cB + (size_t)(t + 2) * kstep;
            const char* a3 = a2 + kstep; const char* b3 = b2 + kstep;
            PG8_LDB(B0, 0, 0); PG8_SCHED; PG8_LDA(At, 0, 0); PG8_STAGE(PG8_SA(1, 1), a1 + hstep, voffA);
            PG8_WAIT_L(8); PG8_BAR; PG8_WAIT_L(0); PG8_MMA(0, 0, At, B0); PG8_BAR; PG8_SCHED;
            PG8_LDB(B1, 0, 1); PG8_STAGE(PG8_SB(0, 0), b2, voffB);
            PG8_BAR; PG8_WAIT_L(0); PG8_MMA(0, 1, At, B1); PG8_BAR;
            PG8_LDA(At, 0, 1); PG8_STAGE(PG8_SA(0, 0), a2, voffA);
            PG8_BAR; PG8_WAIT_L(0); PG8_MMA(1, 0, At, B0); PG8_BAR; PG8_SCHED;
            PG8_STAGE(PG8_SB(0, 1), b2 + hstep, voffB);
            PG8_WAIT_V(6); PG8_BAR; PG8_MMA(1, 1, At, B1); PG8_BAR;
            PG8_LDB(B0, 1, 0); PG8_SCHED; PG8_LDA(At, 1, 0); PG8_STAGE(PG8_SA(0, 1), a2 + hstep, voffA);
            PG8_WAIT_L(8); PG8_BAR; PG8_WAIT_L(0); PG8_MMA(0, 0, At, B0); PG8_BAR; PG8_SCHED;
            PG8_LDB(B1, 1, 1); PG8_STAGE(PG8_SB(1, 0), b3, voffB);
            PG8_BAR; PG8_WAIT_L(0); PG8_MMA(0, 1, At, B1); PG8_BAR;
            PG8_LDA(At, 1, 1); PG8_STAGE(PG8_SA(1, 0), a3, voffA);
            PG8_BAR; PG8_WAIT_L(0); PG8_MMA(1, 0, At, B0); PG8_BAR; PG8_SCHED;
            PG8_STAGE(PG8_SB(1, 1), b3 + hstep, voffB);
            PG8_WAIT_V(6); PG8_BAR; PG8_MMA(1, 1, At, B1); PG8_BAR;
        }
        if constexpr (DUAL) {
            if (part == 1) { E(acc, cur, wr, wc, fr, fq); if (!has_next) break; ++ui; }
            E.scale(acc, cur, wr, wc, fr, fq, part);
            part = npart;
        } else {
            E(acc, cur, wr, wc, fr, fq);
            if (!has_next) break;
#pragma unroll
            for (int a = 0; a < 2; ++a)
#pragma unroll
                for (int b = 0; b < 2; ++b)
#pragma unroll
                    for (int m = 0; m < 4; ++m)
#pragma unroll
                        for (int n = 0; n < 2; ++n) acc[a][b][m][n] = (f32x4){0.f, 0.f, 0.f, 0.f};
            ++ui;
        }
        cur = nxt; cA = nA; cB = nB;
    }
    PG8_WAIT_V(0);
    if (wr == 0) PG8_BAR;
    PG8_BAR;
#undef PG8_SA
#undef PG8_SB
#undef PG8_STAGE
#undef PG8_LDA
#undef PG8_LDB
#undef PG8_MMA
#undef PG8_WAIT_V
#undef PG8_WAIT_L
#undef PG8_BAR
#undef PG8_SCHED
}
}

template <bool UPPERM = false>
DI void transpose_item(const float* W, int K, int N, bf16_t* WT, LAS float* scr, int item, int nblk, int lane) {
    const int kb = item / nblk, nb = item % nblk, k0 = 64 * kb, n0 = 64 * nb;
    const int r0 = UPPERM ? ((n0 % DFF) / 128) * 256 + (n0 / DFF) * 128 + (n0 % 128) : n0;
    const int n4 = (lane & 15) * 4, kk = lane >> 4;
    const bool okn = (n0 + n4) < N;
    f32x4 v[16];
#pragma unroll
    for (int i = 0; i < 16; ++i) v[i] = okn ? *(const f32x4*)(W + (size_t)(k0 + 4 * i + kk) * N + n0 + n4) : (f32x4){0.f, 0.f, 0.f, 0.f};
#pragma unroll
    for (int i = 0; i < 16; ++i) { LAS float* d = scr + (4 * i + kk) * 65 + n4; d[0] = v[i].x; d[1] = v[i].y; d[2] = v[i].z; d[3] = v[i].w; }
    LDS_WAIT();
    const int c = lane & 7;
#pragma unroll
    for (int j = 0; j < 8; ++j) { const int n = (lane >> 3) + 8 * j; const LAS float* sp = scr + (8 * c) * 65 + n;
        u32x4 o; o.x = pk2(sp[0 * 65], sp[1 * 65]); o.y = pk2(sp[2 * 65], sp[3 * 65]); o.z = pk2(sp[4 * 65], sp[5 * 65]); o.w = pk2(sp[6 * 65], sp[7 * 65]);
        *(u32x4*)(WT + (size_t)(r0 + n) * K + k0 + 8 * c) = o; }
    LDS_WAIT();
}
DI void rms_row_bf16(const float* xrow, const float* w, bf16_t* orow, int lane) {
    const f32x4* xr = (const f32x4*)xrow + lane; const f32x4* wr = (const f32x4*)w + lane;
    f32x4 v[8]; float s = 0.f;
#pragma unroll
    for (int j = 0; j < 8; ++j) { v[j] = xr[64 * j]; s += (v[j].x * v[j].x + v[j].y * v[j].y) + (v[j].z * v[j].z + v[j].w * v[j].w); }
    const float rstd = rsqrtf(wave_sum(s) * (1.f / DM) + EPS);
    u32x2* o8 = (u32x2*)orow + lane;
#pragma unroll
    for (int j = 0; j < 8; ++j) { const f32x4 ww = wr[64 * j]; u32x2 o = {pk2(v[j].x * rstd * ww.x, v[j].y * rstd * ww.y), pk2(v[j].z * rstd * ww.z, v[j].w * rstd * ww.w)}; o8[64 * j] = o; }
}
DI void rms_row_f32(float* xrow, const float* w, int lane) {
    f32x4* xr = (f32x4*)xrow + lane; const f32x4* wr = (const f32x4*)w + lane;
    f32x4 v[8]; float s = 0.f;
#pragma unroll
    for (int j = 0; j < 8; ++j) { v[j] = xr[64 * j]; s += (v[j].x * v[j].x + v[j].y * v[j].y) + (v[j].z * v[j].z + v[j].w * v[j].w); }
    const float rstd = rsqrtf(wave_sum(s) * (1.f / DM) + EPS);
#pragma unroll
    for (int j = 0; j < 8; ++j) { const f32x4 ww = wr[64 * j]; xr[64 * j] = v[j] * rstd * ww; }
}

DI void rot_item(int item, bf16_t* PROJ, const float* ROTC, const float* ROTS, bf16_t* KT, bf16_t* VT, LAS unsigned char* lds, int wv) {
    const int tid = tid_(wv); PROJ = lnd(PROJ); ROTC = lnd(ROTC); ROTS = lnd(ROTS); KT = lnd(KT); VT = lnd(VT);
    const int bh = item >> 6, tb = item & 63, bl = bh >> 3, h = bh & 7;
    const int t0 = tb * 64;
    LAS bf16_t* ldsK = (LAS bf16_t*)lds;
    LAS bf16_t* ldsV = (LAS bf16_t*)(lds + 128 * 72 * 2);
    const float lg = log2gamma(h);
    {
        const int t = tid >> 3, seg = tid & 7, pos = t0 + t;
        bf16_t* prow = PROJ + (size_t)(bl * SEQ + pos) * LDP;
        const f32x4 c0 = *(const f32x4*)(ROTC + pos * 64 + seg * 8), c1 = *(const f32x4*)(ROTC + pos * 64 + seg * 8 + 4);
        const f32x4 s0 = *(const f32x4*)(ROTS + pos * 64 + seg * 8), s1 = *(const f32x4*)(ROTS + pos * 64 + seg * 8 + 4);
        const float cs[8] = {c0.x, c0.y, c0.z, c0.w, c1.x, c1.y, c1.z, c1.w}, sn[8] = {s0.x, s0.y, s0.z, s0.w, s1.x, s1.y, s1.z, s1.w};
        {
            bf16_t* p = prow + C_RQ + h * 128 + seg * 8;
            const u32x4 a = *(const u32x4*)p, b = *(const u32x4*)(p + 64);
            float o1[8], o2[8];
#pragma unroll
            for (int j = 0; j < 4; ++j) { const float x1l = bflo(a[j]), x1h = bfhi(a[j]), x2l = bflo(b[j]), x2h = bfhi(b[j]);
                o1[2 * j] = (x1l * cs[2 * j] - x2l * sn[2 * j]) * 0.08838834764831845f; o1[2 * j + 1] = (x1h * cs[2 * j + 1] - x2h * sn[2 * j + 1]) * 0.08838834764831845f;
                o2[2 * j] = (x1l * sn[2 * j] + x2l * cs[2 * j]) * 0.08838834764831845f; o2[2 * j + 1] = (x1h * sn[2 * j + 1] + x2h * cs[2 * j + 1]) * 0.08838834764831845f; }
            u32x4 w1 = {pk2(o1[0], o1[1]), pk2(o1[2], o1[3]), pk2(o1[4], o1[5]), pk2(o1[6], o1[7])}, w2 = {pk2(o2[0], o2[1]), pk2(o2[2], o2[3]), pk2(o2[4], o2[5]), pk2(o2[6], o2[7])};
            *(u32x4*)p = w1; *(u32x4*)(p + 64) = w2;
        }
        {
            bf16_t* p = prow + C_RK + h * 128 + seg * 8;
            const u32x4 a = *(const u32x4*)p, b = *(const u32x4*)(p + 64);
            float o1[8], o2[8];
#pragma unroll
            for (int j = 0; j < 4; ++j) { const float x1l = bflo(a[j]), x1h = bfhi(a[j]), x2l = bflo(b[j]), x2h = bfhi(b[j]);
                o1[2 * j] = x1l * cs[2 * j] - x2l * sn[2 * j]; o1[2 * j + 1] = x1h * cs[2 * j + 1] - x2h * sn[2 * j + 1];
                o2[2 * j] = x1l * sn[2 * j] + x2l * cs[2 * j]; o2[2 * j + 1] = x1h * sn[2 * j + 1] + x2h * cs[2 * j + 1]; }
            u32x4 w1 = {pk2(o1[0], o1[1]), pk2(o1[2], o1[3]), pk2(o1[4], o1[5]), pk2(o1[6], o1[7])}, w2 = {pk2(o2[0], o2[1]), pk2(o2[2], o2[3]), pk2(o2[4], o2[5]), pk2(o2[6], o2[7])};
            *(u32x4*)p = w1; *(u32x4*)(p + 64) = w2;
            const float kw = exp2f(lg * (float)(127 - (pos & 127)));
#pragma unroll
            for (int j = 0; j < 8; ++j) { ldsK[(seg * 8 + j) * 72 + t] = (bf16_t)(pk2(o1[j] * kw, 0.f) & 0xffffu); ldsK[(64 + seg * 8 + j) * 72 + t] = (bf16_t)(pk2(o2[j] * kw, 0.f) & 0xffffu); }
        }
        {
            const bf16_t* p = prow + C_RV + h * 256 + seg * 32;
#pragma unroll
            for (int q = 0; q < 4; ++q) { const u32x4 a = *(const u32x4*)(p + q * 8);
#pragma unroll
                for (int j = 0; j < 4; ++j) { ldsV[(seg * 32 + q * 8 + 2 * j) * 72 + t] = (bf16_t)(a[j] & 0xffffu); ldsV[(seg * 32 + q * 8 + 2 * j + 1) * 72 + t] = (bf16_t)(a[j] >> 16); } }
        }
    }
    __syncthreads();
    {
        const int d = tid >> 2, ts = (tid & 3) * 16;
        const u32x4 a = *(const LAS u32x4*)(ldsK + d * 72 + ts), b = *(const LAS u32x4*)(ldsK + d * 72 + ts + 8);
        bf16_t* o = KT + (size_t)(bh * 128 + d) * SEQ + t0 + ts; *(u32x4*)o = a; *(u32x4*)(o + 8) = b;
        const int e = tid >> 1, tv = (tid & 1) * 32;
        bf16_t* ov = VT + (size_t)(bh * 256 + e) * SEQ + t0 + tv;
#pragma unroll
        for (int q = 0; q < 4; ++q) *(u32x4*)(ov + q * 8) = *(const LAS u32x4*)(ldsV + e * 72 + tv + q * 8);
    }
    __syncthreads();
}

DI void retA_item(int item, const bf16_t* KT, const bf16_t* VT, bf16_t* STATE, int wv) {
    KT = lnd(KT); VT = lnd(VT); STATE = lnd(STATE);
    const int tid = tid_(wv), wid = tid >> 6, lane = tid & 63, r32 = lane & 31, hi = lane >> 5;
    const int bh = item >> 5, c = item & 31;
    const bf16_t* vp = VT + (size_t)(bh * 256 + wid * 32 + r32) * SEQ + c * 128 + hi * 8;
    const bf16_t* kp = KT + (size_t)(bh * 128 + r32) * SEQ + c * 128 + hi * 8;
    f32x16 acc[4] = {};
#pragma unroll
    for (int ks = 0; ks < 8; ++ks) {
        const bf16x8 a = *(const bf16x8*)(vp + ks * 16);
#pragma unroll
        for (int dt = 0; dt < 4; ++dt) { const bf16x8 b = *(const bf16x8*)(kp + (size_t)dt * 32 * SEQ + ks * 16); acc[dt] = MFMA32(a, b, acc[dt]); }
    }
    bf16_t* so = STATE + (size_t)(bh * 32 + c) * 32768;
#pragma unroll
    for (int dt = 0; dt < 4; ++dt)
#pragma unroll
        for (int r = 0; r < 16; ++r) so[(((wid * 8 + dt * 2 + (r32 >> 4)) * 64 + ((r32 >> 3) & 1) * 32 + crow(r, hi)) << 3) + (r32 & 7)] = (bf16_t)(pk2(acc[dt][r], 0.f) & 0xffffu);
}
DI void retB_scan(bf16_t* STATE, int gtid, int wv) {
    STATE = lnd(STATE);
    const int bh = gtid >> 13, rem = gtid & 8191;
    const float dec = exp2f(log2gamma(bh & 7) * 128.f);
    float s0 = 0.f, s1 = 0.f, s2 = 0.f, s3 = 0.f;
    bf16_t* p = STATE + (size_t)bh * 32 * 32768 + (size_t)rem * 4;
    u32x2 kv[32];
#pragma unroll
    for (int c = 0; c < 32; ++c) kv[c] = *(const u32x2*)(p + (size_t)c * 32768);
#pragma unroll
    for (int c = 0; c < 32; ++c) {
        u32x2 o = {pk2(s0, s1), pk2(s2, s3)}; *(u32x2*)(p + (size_t)c * 32768) = o;
        s0 = s0 * dec + bflo(kv[c][0]); s1 = s1 * dec + bfhi(kv[c][0]); s2 = s2 * dec + bflo(kv[c][1]); s3 = s3 * dec + bfhi(kv[c][1]);
    }
}
DI void retC_item(int item, const bf16_t* PROJ, const bf16_t* VT, const bf16_t* STATE, const float* ret_w, bf16_t* ARET, LAS unsigned char* lds, int wv) {
    PROJ = lnd(PROJ); VT = lnd(VT); STATE = lnd(STATE); ret_w = lnd(ret_w); ARET = lnd(ARET);
    const int tid = tid_(wv), wid = tid >> 6, lane = tid & 63, r32 = lane & 31, hi = lane >> 5;
    const int bh = item >> 5, c = item & 31, bl = bh >> 3, h = bh & 7;
    const int nb = wid & 3, eh = wid >> 2;
    const float lg = log2gamma(h);
    const size_t rowbase = (size_t)bl * SEQ + c * 128;
    const int ntok = nb * 32 + r32;
    bf16x8 qf[8];
    { const bf16_t* qp = PROJ + (rowbase + ntok) * LDP + C_RQ + h * 128 + hi * 8;
#pragma unroll
      for (int ds = 0; ds < 8; ++ds) qf[ds] = *(const bf16x8*)(qp + ds * 16); }
    LAS unsigned char* ldsK = lds; LAS unsigned char* ldsV = lds + 32768;
    {
        const int kr = tid >> 4, kc = tid & 15;
        const bf16_t* ksrc = PROJ + (rowbase + kr) * LDP + C_RK + h * 128 + kc * 8;
        const bf16_t* vsrc = VT + (size_t)(bh * 256 + kr) * SEQ + c * 128 + kc * 8;
        u32x4 kv[4], vv[8];
#pragma unroll
        for (int j = 0; j < 4; ++j) kv[j] = *(const u32x4*)(ksrc + (size_t)j * 32 * LDP);
#pragma unroll
        for (int j = 0; j < 8; ++j) vv[j] = *(const u32x4*)(vsrc + (size_t)j * 32 * SEQ);
#pragma unroll
        for (int j = 0; j < 4; ++j) { const int row = j * 32 + kr; *(LAS u32x4*)(ldsK + row * 256 + ((kc ^ (row & 15)) << 4)) = kv[j]; }
#pragma unroll
        for (int j = 0; j < 8; ++j) { const int row = j * 32 + kr, x = row & 31; u32x2 lo = {vv[j][0], vv[j][1]}, hh = {vv[j][2], vv[j][3]};
            *(LAS u32x2*)(ldsV + row * 256 + (((2 * kc) ^ x) << 3)) = lo; *(LAS u32x2*)(ldsV + row * 256 + (((2 * kc + 1) ^ x) << 3)) = hh; }
    }
    __syncthreads();
    f32x16 o[4] = {};
    const int kx = r32 & 15;
    for (int mb = 0; mb <= nb; ++mb) {
        f32x16 pt = {};
        const LAS unsigned char* kb = ldsK + (mb * 32 + r32) * 256;
#pragma unroll
        for (int ds = 0; ds < 8; ++ds) pt = MFMA32(*(const LAS bf16x8*)(kb + (((2 * ds + hi) ^ kx) << 4)), qf[ds], pt);
#pragma unroll
        for (int r = 0; r < 16; ++r) { const int dd = ntok - (mb * 32 + crow(r, hi)); pt[r] = dd >= 0 ? pt[r] * exp2f(lg * (float)dd) : 0.f; }
#pragma unroll
        for (int s2 = 0; s2 < 2; ++s2) {
            u32x4 pw = {pk2(pt[8 * s2], pt[8 * s2 + 1]), pk2(pt[8 * s2 + 2], pt[8 * s2 + 3]), pk2(pt[8 * s2 + 4], pt[8 * s2 + 5]), pk2(pt[8 * s2 + 6], pt[8 * s2 + 7])};
            const bf16x8 pb = __builtin_bit_cast(bf16x8, pw);
            const int gq = 8 * mb + 4 * s2 + hi;
#pragma unroll
            for (int et = 0; et < 4; ++et) {
                const LAS unsigned char* vrow = ldsV + (eh * 128 + et * 32 + r32) * 256;
                const u32x2 lo = *(const LAS u32x2*)(vrow + ((gq ^ r32) << 3)), hh = *(const LAS u32x2*)(vrow + (((gq + 2) ^ r32) << 3));
                u32x4 aw = {lo[0], lo[1], hh[0], hh[1]};
                o[et] = MFMA32(__builtin_bit_cast(bf16x8, aw), pb, o[et]);
            }
        }
    }
    f32x16 cr[4] = {};
    { const bf16_t* sp = STATE + (size_t)(bh * 32 + c) * 32768 + (size_t)(eh * 4 * 8 * 64 + lane) * 8;
#pragma unroll
      for (int ds = 0; ds < 8; ++ds)
#pragma unroll
          for (int et = 0; et < 4; ++et) cr[et] = MFMA32(*(const bf16x8*)(sp + (size_t)((et * 8 + ds) * 64) * 8), qf[ds], cr[et]); }
    const float qd = exp2f(lg * (float)(ntok + 1));
    float ss = 0.f;
#pragma unroll
    for (int et = 0; et < 4; ++et)
#pragma unroll
        for (int r = 0; r < 16; ++r) { const float v = o[et][r] + cr[et][r] * qd; o[et][r] = v; ss += v * v; }
    ss = sum32(ss);
    LAS float* ex = (LAS float*)(lds + 133120);
    if (hi == 0) ex[wid * 32 + r32] = ss;
    __syncthreads();
    const float tot = ex[wid * 32 + r32] + ex[(wid ^ 4) * 32 + r32];
    const float rstd = rsqrtf(tot * (1.f / 256.f) + EPS);
    {
        LAS unsigned char* trow = lds + ntok * 1040 + (eh * 128 + 4 * hi) * 4;
#pragma unroll
        for (int et = 0; et < 4; ++et)
#pragma unroll
            for (int q = 0; q < 4; ++q) { f32x4 v = {o[et][4 * q] * rstd, o[et][4 * q + 1] * rstd, o[et][4 * q + 2] * rstd, o[et][4 * q + 3] * rstd}; *(LAS f32x4*)(trow + (et * 32 + 8 * q) * 4) = v; }
    }
    __syncthreads();
#pragma unroll
    for (int j = 0; j < 8; ++j) {
        const int p = tid + 512 * j, tok = p >> 5, e8 = (p & 31) * 8;
        const f32x4 a = *(const LAS f32x4*)(lds + tok * 1040 + e8 * 4), b = *(const LAS f32x4*)(lds + tok * 1040 + e8 * 4 + 16);
        const u32x4 g = *(const u32x4*)(PROJ + (rowbase + tok) * LDP + C_RG + h * 256 + e8);
        const f32x4 w0 = *(const f32x4*)(ret_w + h * 256 + e8), w1 = *(const f32x4*)(ret_w + h * 256 + e8 + 4);
        u32x4 ow = {pk2(a[0] * w0.x * siluf_(bflo(g[0])), a[1] * w0.y * siluf_(bfhi(g[0]))), pk2(a[2] * w0.z * siluf_(bflo(g[1])), a[3] * w0.w * siluf_(bfhi(g[1]))),
                    pk2(b[0] * w1.x * siluf_(bflo(g[2])), b[1] * w1.y * siluf_(bfhi(g[2]))), pk2(b[2] * w1.z * siluf_(bflo(g[3])), b[3] * w1.w * siluf_(bfhi(g[3])))};
        *(u32x4*)(ARET + (rowbase + tok) * DM + h * 256 + e8) = ow;
    }
    __syncthreads();
}

DI float gelu_tanh(float x) { const float u = 0.7978845608028654f * (x + 0.044715f * x * x * x); const float e = __expf(2.f * u); const float t = 1.f - 2.f / (e + 1.f); return 0.5f * x * (1.f + t); }
DI void cmp_item(int item, int hf, const bf16_t* PROJ, const float* pe_k, const float* pe_v, const bf16_t* W1K, const bf16_t* W1V, const bf16_t* W2K, const bf16_t* W2V,
                 float* KP, float* VP, LAS unsigned char* lds, int wv) {
    PROJ = lnd(PROJ); KP = lnd(KP); VP = lnd(VP);
    const int tid = tid_(wv), wid = tid >> 6, lane = tid & 63, fr = lane & 15, kq = lane >> 4;
    const int h2 = item & 1, rg = (item >> 1) & 15, g = (item >> 5) & 1, bl = (item >> 6) & 1, kv = item >> 7;
    const float* pe = lnd(kv ? pe_v : pe_k); const bf16_t* W1 = lnd(kv ? W1V : W1K); const bf16_t* W2 = lnd(kv ? W2V : W2K);
    const int ccol = (kv ? C_VC : C_KC) + g * 128;
    const int i_raw = rg * 16 + fr, ib = i_raw > 254 ? 254 : i_raw;
    const bf16_t* arow = PROJ + (size_t)(bl * SEQ + 16 * ib) * LDP + ccol + 8 * kq;
    const bf16_t* bp = W1 + (size_t)(h2 * 128 + fr) * 4096 + 8 * kq;
    f32x4 acc[8];
#pragma unroll
    for (int nt = 0; nt < 8; ++nt) acc[nt] = (f32x4){0.f, 0.f, 0.f, 0.f};
#define CMP_LOAD(XA, P0, P1, BF, kk_) do { const int ks_ = wid * 16 + (kk_), l_ = ks_ >> 2, d0_ = (ks_ & 3) * 32; XA = *(const u32x4*)(arow + (size_t)l_ * LDP + d0_); \
        const float* pp_ = pe + l_ * 128 + d0_ + 8 * kq; P0 = *(const f32x4*)pp_; P1 = *(const f32x4*)(pp_ + 4); \
        _Pragma("unroll") for (int nt = 0; nt < 8; ++nt) BF[nt] = *(const bf16x8*)(bp + (size_t)nt * 16 * 4096 + ks_ * 32); } while (0)
#define CMP_MMA(XA, P0, P1, BF) do { u32x4 aw = {pk2(bflo(XA[0]) + P0.x, bfhi(XA[0]) + P0.y), pk2(bflo(XA[1]) + P0.z, bfhi(XA[1]) + P0.w), pk2(bflo(XA[2]) + P1.x, bfhi(XA[2]) + P1.y), pk2(bflo(XA[3]) + P1.z, bfhi(XA[3]) + P1.w)}; \
        const bf16x8 af = __builtin_bit_cast(bf16x8, aw); _Pragma("unroll") for (int nt = 0; nt < 8; ++nt) acc[nt] = MFMA16(af, BF[nt], acc[nt]); } while (0)
    {
        u32x4 xaA, xaB; f32x4 pA0, pA1, pB0, pB1; bf16x8 bfA[8], bfB[8];
        CMP_LOAD(xaA, pA0, pA1, bfA, 0);
        for (int kk = 0; kk < 16; kk += 2) {
            CMP_LOAD(xaB, pB0, pB1, bfB, kk + 1);
            CMP_MMA(xaA, pA0, pA1, bfA);
            if (kk + 2 < 16) CMP_LOAD(xaA, pA0, pA1, bfA, kk + 2);
            CMP_MMA(xaB, pB0, pB1, bfB);
        }
    }
#undef CMP_LOAD
#undef CMP_MMA
    LAS float* red = (LAS float*)lds;
    LAS bf16_t* hid = (LAS bf16_t*)(lds + 65536);
#pragma unroll
    for (int nt = 0; nt < 8; ++nt)
#pragma unroll
        for (int r = 0; r < 4; ++r) red[(wid * 16 + 4 * kq + r) * 128 + nt * 16 + fr] = acc[nt][r];
    __syncthreads();
#pragma unroll
    for (int e = 0; e < 4; ++e) {
        const int idx = e * 512 + tid;
        float v = 0.f;
#pragma unroll
        for (int w = 0; w < 8; ++w) v += red[w * 2048 + idx];
        hid[(idx >> 7) * 136 + (idx & 127)] = (bf16_t)(pk2(gelu_tanh(v), 0.f) & 0xffffu);
    }
    __syncthreads();
    f32x4 o = {0.f, 0.f, 0.f, 0.f};
    const bf16_t* w2p = W2 + (size_t)(wid * 16 + fr) * 256 + h2 * 128 + 8 * kq;
#pragma unroll
    for (int ks = 0; ks < 4; ++ks) o = MFMA16(*(const LAS bf16x8*)(hid + fr * 136 + ks * 32 + 8 * kq), *(const bf16x8*)(w2p + ks * 32), o);
    const int bg = (hf * 2 + bl) * 2 + g;
    const int d = wid * 16 + fr;
    if (kv == 0) {
        float* kp = KP + (size_t)h2 * (8 * 256 * 128);
#pragma unroll
        for (int r = 0; r < 4; ++r) { const int i = rg * 16 + 4 * kq + r; kp[((size_t)bg * 256 + i) * 128 + d] = i < 255 ? o[r] : 0.f; }
    } else {
        float* vp = VP + (size_t)h2 * (8 * 128 * 256);
        const int i0 = rg * 16 + 4 * kq;
        f32x4 w = {o[0], o[1], o[2], (i0 + 3 < 255) ? o[3] : 0.f};
        *(f32x4*)(vp + ((size_t)bg * 128 + d) * 256 + i0) = w;
    }
    __syncthreads();
}

DI void cattn_item(int item, int hf, const bf16_t* PROJ, const float* KP, const float* VP, float* NSAF, unsigned* SEL, LAS unsigned char* lds, int wv) {
    PROJ = lnd(PROJ); KP = lnd(KP); VP = lnd(VP); NSAF = lnd(NSAF); SEL = lnd(SEL);
    const int tid = tid_(wv), wid = tid >> 6, lane = tid & 63, r32 = lane & 31, hi = lane >> 5;
    const int g = (item >> 7) & 1, bl = item >> 8;
    const int tb = bl ? 127 - (item & 127) : (item & 127);
    const int bg = (hf * 2 + bl) * 2 + g, head = g * 8 + wid;
    const int t = tb * 32 + r32;
    const size_t lrow = (size_t)bl * SEQ + t;
    const int ntile = (tb >> 4) + 1;
    LAS unsigned char* ldsK = lds; LAS unsigned char* ldsV = lds + 65536;
    bf16x8 qf[8];
    { const bf16_t* qp = PROJ + lrow * LDP + C_NQ + head * 128 + hi * 8;
#pragma unroll
      for (int ds = 0; ds < 8; ++ds) qf[ds] = *(const bf16x8*)(qp + ds * 16); }
    {
        const int kr = tid >> 4, kc = tid & 15;
        const float* ksrc = KP + ((size_t)bg * 256 + kr) * 128 + kc * 8;
        const int vr = tid >> 2, vc = tid & 3;
        const float* vsrc = VP + ((size_t)bg * 128 + vr) * 256 + vc * 8;
#pragma unroll
        for (int jb = 0; jb < 8; jb += 4) {
            if (jb < ntile) {
                f32x4 ka[4], kb2[4], va[4], vb2[4];
#pragma unroll
                for (int jj = 0; jj < 4; ++jj) {
                    const int j = jb + jj;
                    if (j < ntile) {
                        const float* kp0 = ksrc + (size_t)j * 32 * 128; const float* kp1 = kp0 + 8 * 256 * 128;
                        ka[jj] = *(const f32x4*)kp0 + *(const f32x4*)kp1; kb2[jj] = *(const f32x4*)(kp0 + 4) + *(const f32x4*)(kp1 + 4);
                        const float* vp0 = vsrc + j * 32; const float* vp1 = vp0 + 8 * 128 * 256;
                        va[jj] = *(const f32x4*)vp0 + *(const f32x4*)vp1; vb2[jj] = *(const f32x4*)(vp0 + 4) + *(const f32x4*)(vp1 + 4);
                    }
                }
#pragma unroll
                for (int jj = 0; jj < 4; ++jj) {
                    const int j = jb + jj;
                    if (j < ntile) {
                        const int row = j * 32 + kr;
                        u32x4 kv = {pk2(ka[jj][0], ka[jj][1]), pk2(ka[jj][2], ka[jj][3]), pk2(kb2[jj][0], kb2[jj][1]), pk2(kb2[jj][2], kb2[jj][3])};
                        *(LAS u32x4*)(ldsK + row * 256 + ((kc ^ (row & 15)) << 4)) = kv;
                        const int g0 = 2 * (vc + 4 * j), x = vr & 31;
                        u32x2 lo = {pk2(va[jj][0], va[jj][1]), pk2(va[jj][2], va[jj][3])}, hh = {pk2(vb2[jj][0], vb2[jj][1]), pk2(vb2[jj][2], vb2[jj][3])};
                        *(LAS u32x2*)(ldsV + vr * 512 + ((g0 ^ x) << 3)) = lo;
                        *(LAS u32x2*)(ldsV + vr * 512 + (((g0 + 1) ^ x) << 3)) = hh;
                    }
                }
            }
        }
    }
    __syncthreads();
    f32x16 s[8];
    const int imax = (t - 31) >> 4;
    float mx = -__builtin_inff();
    const int kx = r32 & 15;
#pragma unroll
    for (int kt = 0; kt < 8; ++kt) {
        s[kt] = f32x16{};
        if (kt < ntile) {
            const LAS unsigned char* kb = ldsK + (kt * 32 + r32) * 256;
#pragma unroll
            for (int ds = 0; ds < 8; ++ds) s[kt] = MFMA32(*(const LAS bf16x8*)(kb + (((2 * ds + hi) ^ kx) << 4)), qf[ds], s[kt]);
        }
#pragma unroll
        for (int r = 0; r < 16; ++r) { const int i = kt * 32 + crow(r, hi); const float v = (kt < ntile && i <= imax) ? s[kt][r] * 0.08838834764831845f : -__builtin_inff(); s[kt][r] = v; mx = fmaxf(mx, v); }
    }
    mx = fmaxf(mx, xor32(mx, hi));
    if (mx == -__builtin_inff()) mx = 0.f;
    float sum = 0.f;
#pragma unroll
    for (int kt = 0; kt < 8; ++kt)
#pragma unroll
        for (int r = 0; r < 16; ++r) { const float p = __expf(s[kt][r] - mx); s[kt][r] = p; sum += p; }
    sum = sum32(sum);
    const float inv = 1.f / fmaxf(sum, 1e-30f);
    f32x16 o[4] = {};
#pragma unroll
    for (int kt = 0; kt < 8; ++kt) {
#pragma unroll
        for (int r = 0; r < 16; ++r) s[kt][r] *= inv;
        if (kt < ntile) {
#pragma unroll
            for (int st = 0; st < 2; ++st) {
                u32x4 pw = {pk2(s[kt][8 * st], s[kt][8 * st + 1]), pk2(s[kt][8 * st + 2], s[kt][8 * st + 3]), pk2(s[kt][8 * st + 4], s[kt][8 * st + 5]), pk2(s[kt][8 * st + 6], s[kt][8 * st + 7])};
                const bf16x8 pb = __builtin_bit_cast(bf16x8, pw);
                const int gq = 8 * kt + 4 * st + hi;
#pragma unroll
                for (int dt = 0; dt < 4; ++dt) {
                    const LAS unsigned char* vrow = ldsV + (dt * 32 + r32) * 512;
                    const u32x2 lo = *(const LAS u32x2*)(vrow + ((gq ^ r32) << 3)), hh = *(const LAS u32x2*)(vrow + (((gq + 2) ^ r32) << 3));
                    u32x4 aw = {lo[0], lo[1], hh[0], hh[1]};
                    o[dt] = MFMA32(__builtin_bit_cast(bf16x8, aw), pb, o[dt]);
                }
            }
        }
    }
    {
        const float gate = sigmoidf_(bf2f(PROJ[lrow * LDP + C_NG + head * 3 + 0]));
        float* op = NSAF + lrow * DM + head * 128;
#pragma unroll
        for (int dt = 0; dt < 4; ++dt)
#pragma unroll
            for (int q = 0; q < 4; ++q) { f32x4 v = {o[dt][4 * q] * gate, o[dt][4 * q + 1] * gate, o[dt][4 * q + 2] * gate, o[dt][4 * q + 3] * gate}; *(f32x4*)(op + dt * 32 + 8 * q + 4 * hi) = v; }
    }
    __syncthreads();
    LAS float* slab = (LAS float*)lds;
    {
        float plprev = 0.f;
#pragma unroll
        for (int kt = 0; kt < 8; ++kt)
#pragma unroll
            for (int q = 0; q < 4; ++q) {
                const float gsum = (s[kt][4 * q] + s[kt][4 * q + 1]) + (s[kt][4 * q + 2] + s[kt][4 * q + 3]);
                const float pl = xor32(s[kt][4 * q + 3], hi);
                const float add = hi ? pl : plprev;
                slab[(wid * 32 + r32) * 65 + 8 * kt + 2 * q + hi] = gsum + add;
                plprev = pl;
            }
    }
    __syncthreads();
    LAS float* imps = (LAS float*)(lds + 131072);
    const int c = tid >> 4, j4 = (tid & 15) * 4;
#pragma unroll
    for (int k = 0; k < 4; ++k) { float v = 0.f;
#pragma unroll
        for (int w = 0; w < 8; ++w) v += slab[(w * 32 + c) * 65 + j4 + k];
        imps[c * 65 + j4 + k] = v; }
    __syncthreads();
    {
        const int tt = tb * 32 + c, cur = tt >> 6;
        float myv[4];
#pragma unroll
        for (int k = 0; k < 4; ++k) { const int sb = j4 + k; myv[k] = (sb == 0 || sb == cur || sb == cur - 1) ? 1e4f : (sb > cur ? -1e4f : imps[c * 65 + sb]); }
        int rank[4] = {0, 0, 0, 0};
        for (int sb2 = 0; sb2 < 64; ++sb2) {
            const float v2 = (sb2 == 0 || sb2 == cur || sb2 == cur - 1) ? 1e4f : (sb2 > cur ? -1e4f : imps[c * 65 + sb2]);
#pragma unroll
            for (int k = 0; k < 4; ++k) rank[k] += (v2 > myv[k] || (v2 == myv[k] && sb2 < j4 + k)) ? 1 : 0;
        }
        unsigned lo = 0, hh = 0;
#pragma unroll
        for (int k = 0; k < 4; ++k) { const int sb = j4 + k; if (rank[k] < 16 && sb <= cur) { if (sb < 32) lo |= 1u << sb; else hh |= 1u << (sb - 32); } }
        lo |= swzu<1>(lo); hh |= swzu<1>(hh); lo |= swzu<2>(lo); hh |= swzu<2>(hh); lo |= swzu<4>(lo); hh |= swzu<4>(hh); lo |= swzu<8>(lo); hh |= swzu<8>(hh);
        if ((tid & 15) == 0) { u32x2 w = {lo, hh}; *(u32x2*)(SEL + ((size_t)bg * SEQ + tt) * 2) = w; }
    }
    __syncthreads();
}

namespace att {
constexpr float SCALE = 0.08838834764831845f;
constexpr int NW = 8, QBLK = 32, KVBLK = 64, QB = 256, D = 128;
constexpr int SHM_V = KVBLK * D * 2, SHM_K = KVBLK * D * 2;
constexpr int LDS_NEED = 2 * SHM_V + 2 * SHM_K + NW * 64 * 4;
constexpr float THR = 8.f;
#define KSWZ(row, colB) ((row) * 256 + ((colB) ^ (((row) & 7) << 4)))
#define SBAR() __builtin_amdgcn_sched_barrier(0)
DI int v_st(int k, int c) { const int kk = (k & ~0xC) | ((k & 4) << 1) | ((k & 8) >> 1); return ((kk >> 3) * 4 + (c >> 5)) * 512 + ((kk & 7) * 32 + (c & 31)) * 2; }
DI int v_rd_base(int lane) { return ((lane & 3) << 3) | (((lane >> 2) & 3) << 6) | (((lane >> 4) & 1) << 5) | (((lane >> 5) & 1) << 8); }
constexpr int v_rd_off(int d0, int ks, int half) { return d0 * 512 + ks * 4096 + half * 2048; }
DI unsigned cvtpk(float lo, float hi) { unsigned r; asm volatile("v_cvt_pk_bf16_f32 %0, %1, %2" : "=v"(r) : "v"(lo), "v"(hi)); return r; }
DI bf16x8 load8(const bf16_t* p) { return *reinterpret_cast<const bf16x8*>(p); }
DI void mask_tile(f32x16& p0, f32x16& p1, int dq, unsigned W) {
    const float NEG = -__builtin_inff();
#pragma unroll
    for (int r = 0; r < 16; ++r) {
        const int c = (r & 3) + 8 * (r >> 2);
        if ((unsigned)(dq - c) >= W) p0[r] = NEG;
        if ((unsigned)(dq - c - 32) >= W) p1[r] = NEG;
    }
}
DI void partialSM(f32x16& p0, f32x16& p1, float& m_reg, float& mn, float& alpha) {
    float pmax = p0[0]; for (int r = 1; r < 16; ++r) pmax = fmaxf(pmax, p0[r]); for (int r = 0; r < 16; ++r) pmax = fmaxf(pmax, p1[r]);
    { auto rr = __builtin_amdgcn_permlane32_swap(__float_as_uint(pmax), __float_as_uint(pmax), false, false);
      pmax = fmaxf(__uint_as_float(rr[0]), __uint_as_float(rr[1])); }
    constexpr float C2 = 1.4426950408889634f * SCALE;
    if (__builtin_expect(__all((pmax - m_reg) * SCALE <= THR), 1)) { mn = m_reg; alpha = 1.f; }
    else { mn = fmaxf(m_reg, pmax); alpha = __builtin_amdgcn_exp2f((m_reg - mn) * C2); m_reg = mn; }
    const float mnL = -mn * C2;
    for (int r = 0; r < 16; ++r) p0[r] = fmaf(p0[r], C2, mnL); for (int r = 0; r < 16; ++r) p1[r] = fmaf(p1[r], C2, mnL);
    for (int r = 0; r < 16; ++r) p0[r] = __builtin_amdgcn_exp2f(p0[r]);
}
DI void finishSM(f32x16& p0, f32x16& p1, float alpha, float& l_reg, bf16x8& pa0, bf16x8& pa1, bf16x8& pa2, bf16x8& pa3) {
    for (int r = 0; r < 16; ++r) p1[r] = __builtin_amdgcn_exp2f(p1[r]);
    float ps = 0; for (int r = 0; r < 16; ++r) ps += p0[r]; for (int r = 0; r < 16; ++r) ps += p1[r];
    { auto rr = __builtin_amdgcn_permlane32_swap(__float_as_uint(ps), __float_as_uint(ps), false, false);
      ps = __uint_as_float(rr[0]) + __uint_as_float(rr[1]); }
    l_reg = l_reg * alpha + ps;
#define PK4(P, B_, OUT) do { unsigned a0 = cvtpk(P[B_+0], P[B_+1]), a1 = cvtpk(P[B_+2], P[B_+3]);                          \
        unsigned b0 = cvtpk(P[B_+4], P[B_+5]), b1 = cvtpk(P[B_+6], P[B_+7]);                                             \
        auto r0 = __builtin_amdgcn_permlane32_swap(a0, b0, false, false); auto r1 = __builtin_amdgcn_permlane32_swap(a1, b1, false, false); \
        u32x4 w = {r0[0], r1[0], r0[1], r1[1]}; OUT = *reinterpret_cast<bf16x8*>(&w); } while (0)
    PK4(p0, 0, pa0); PK4(p0, 8, pa1); PK4(p1, 0, pa2); PK4(p1, 8, pa3);
#undef PK4
}
template <int KB>
DI void qkt(f32x16& p0, f32x16& p1, const char* K_lds, int r32, int hi, const bf16x8* qr) {
    p0 = f32x16{}; p1 = f32x16{};
    const char* kb[4];
#pragma unroll
    for (int dd = 0; dd < 4; ++dd) kb[dd] = K_lds + KB * SHM_K + KSWZ(r32, (dd * 16 + hi * 8) * 2);
#pragma unroll
    for (int d0 = 0; d0 < 8; ++d0) { const char* a = kb[d0 & 3] + (d0 >> 2) * 128;
        bf16x8 b0 = *reinterpret_cast<const bf16x8*>(a);
        bf16x8 b1 = *reinterpret_cast<const bf16x8*>(a + 32 * 256);
        p0 = __builtin_amdgcn_mfma_f32_32x32x16_bf16(b0, qr[d0], p0, 0, 0, 0);
        p1 = __builtin_amdgcn_mfma_f32_32x32x16_bf16(b1, qr[d0], p1, 0, 0, 0); }
}
template <int VB>
DI void pv_tile(f32x16* o, int vb0, bf16x8 pa0, bf16x8 pa1, bf16x8 pa2, bf16x8 pa3) {
#define TRRD(dst, off) asm volatile("ds_read_b64_tr_b16 %0, %1 offset:%2" : "=&v"(dst) : "v"(vb0), "i"(off) : "memory")
#define PV_D0(d0) do { s16x4 l0, l1, l2, l3, h0, h1, h2, h3; constexpr int b_ = VB * SHM_V + v_rd_off(d0, 0, 0); \
        TRRD(l0, b_); TRRD(h0, b_ + 2048); TRRD(l1, b_ + 4096); TRRD(h1, b_ + 6144); TRRD(l2, b_ + 8192); TRRD(h2, b_ + 10240); TRRD(l3, b_ + 12288); TRRD(h3, b_ + 14336); \
        asm volatile("s_waitcnt lgkmcnt(0)" ::: "memory"); SBAR();   \
        o[d0] = __builtin_amdgcn_mfma_f32_32x32x16_bf16(pa0, (bf16x8){l0[0], l0[1], l0[2], l0[3], h0[0], h0[1], h0[2], h0[3]}, o[d0], 0, 0, 0);   \
        o[d0] = __builtin_amdgcn_mfma_f32_32x32x16_bf16(pa1, (bf16x8){l1[0], l1[1], l1[2], l1[3], h1[0], h1[1], h1[2], h1[3]}, o[d0], 0, 0, 0);   \
        o[d0] = __builtin_amdgcn_mfma_f32_32x32x16_bf16(pa2, (bf16x8){l2[0], l2[1], l2[2], l2[3], h2[0], h2[1], h2[2], h2[3]}, o[d0], 0, 0, 0);   \
        o[d0] = __builtin_amdgcn_mfma_f32_32x32x16_bf16(pa3, (bf16x8){l3[0], l3[1], l3[2], l3[3], h3[0], h3[1], h3[2], h3[3]}, o[d0], 0, 0, 0); } while (0)
    PV_D0(0); PV_D0(1); PV_D0(2); PV_D0(3);
#undef PV_D0
#undef TRRD
}
struct BlockRef { const bf16_t* Q; const bf16_t* K; const bf16_t* V; float* Of; bf16_t* Ob; const unsigned* sel; const bf16_t* gate; int P0; int W; int mode; };
struct Seam { bf16x8 qr[8]; bf16x8 st_v0, st_v1, st_k0, st_k1; };
DI int swa_jlo(int P0, int W) { const int lowk = P0 - W + 1; return lowk > 0 ? lowk / KVBLK : 0; }
#define ROW(p, k0, rr) ((p) + (size_t)((k0) + (rr)) * LDP + sc)
#define VMW() asm volatile("s_waitcnt vmcnt(0)" ::: "memory")
#define VMWN(n) asm volatile("s_waitcnt vmcnt(%0)" :: "i"(n) : "memory")
#define SLOAD_H(Kp, Vp, k0) do { S.st_v0 = load8(ROW(Vp, k0, sr)); S.st_v1 = load8(ROW(Vp, k0, 32 + sr));              \
                         S.st_k0 = load8(ROW(Kp, k0, sr)); S.st_k1 = load8(ROW(Kp, k0, 32 + sr)); } while (0)
#define SWRITE_HK(bf) do { *(bf16x8*)(K_lds + (bf) * SHM_K + kws) = S.st_k0; *(bf16x8*)(K_lds + (bf) * SHM_K + kws + 32 * 256) = S.st_k1; } while (0)
#define SWRITE_HV(bf) do { *(bf16x8*)(V_lds + (bf) * SHM_V + vst0) = S.st_v0; *(bf16x8*)(V_lds + (bf) * SHM_V + vst1) = S.st_v1; } while (0)
#define SWRITE_H(bf) do { SWRITE_HV(bf); SWRITE_HK(bf); } while (0)
DI BlockRef make_ref(int L, int step, int hf, const bf16_t* PROJ, float* NSAF, bf16_t* NSA, const unsigned* SEL) {
    const int y = L & 7, head = (L >> 3) & 15, bl = L >> 7, g = head >> 3;
    const int qb = (step & 2) ? 15 - y : y, win = step & 1;
    const int P0 = qb * QB;
    const size_t lrow0 = (size_t)bl * SEQ;
    BlockRef r;
    r.Q = PROJ + (lrow0 + P0) * LDP + C_NQ + head * 128;
    r.K = PROJ + lrow0 * LDP + (win ? C_KW : C_KS) + g * 128;
    r.V = PROJ + lrow0 * LDP + (win ? C_VW : C_VS) + g * 128;
    r.Of = NSAF + (lrow0 + P0) * DM + head * 128;
    r.Ob = NSA + (lrow0 + P0) * DM + head * 128;
    r.sel = win ? nullptr : SEL + ((size_t)((hf * 2 + bl) * 2 + g) * SEQ + P0) * 2;
    r.gate = PROJ + (lrow0 + P0) * LDP + C_NG + head * 3 + (win ? 2 : 1);
    r.P0 = P0; r.W = win ? 512 : (1 << 30); r.mode = win;
    return r;
}
DI void prime(const BlockRef& cur, char* lds, Seam& S, int wv) {
    const int tid = tid_(wv), wid = __builtin_amdgcn_readfirstlane(tid >> 6), lane = tid & 63, r32 = lane & 31, hi = lane >> 5;
    const int sr = tid >> 4, sc = (tid & 15) * 8, kws = KSWZ(sr, sc * 2); char* K_lds = lds + 2 * SHM_V;
    const int kb0 = swa_jlo(cur.P0, cur.W) * KVBLK;
    for (int d0 = 0; d0 < 8; ++d0) S.qr[d0] = load8(cur.Q + (size_t)(wid * QBLK + r32) * LDP + d0 * 16 + hi * 8);
    SLOAD_H(cur.K, cur.V, kb0); VMW(); SWRITE_HK(0);
    __syncthreads();
}
DI void block(const BlockRef& cur, int Ln, int stepn, int hf, const bf16_t* PROJ, float* NSAF, bf16_t* NSA, const unsigned* SEL, int skv, char* lds, Seam& S, int wv) {
    const int tid = tid_(wv), wid = __builtin_amdgcn_readfirstlane(tid >> 6), lane = tid & 63, r32 = lane & 31, hi = lane >> 5;
    const int W = cur.W;
    const int j_lo = swa_jlo(cur.P0, W);
    int j_hi = (cur.P0 + QB - 1) / KVBLK + 1; if (j_hi > skv / KVBLK) j_hi = skv / KVBLK;
    const int NT_ = j_hi - j_lo;
    const int qlo = cur.P0 + wid * QBLK, qm = qlo + r32 - 4 * hi;
    char* V_lds = lds; char* K_lds = lds + 2 * SHM_V;
    float* ws = (float*)(lds + 2 * SHM_V + 2 * SHM_K) + wid * 64; float* li_l = ws, * al_l = ws + 32;
    float m_reg = -1e30f, l_reg = 0; f32x16 o[4] = {};
    const int sr = tid >> 4, sc = (tid & 15) * 8, vst0 = v_st(sr, sc), vst1 = v_st(32 + sr, sc), kws = KSWZ(sr, sc * 2);
    const int vb0 = (int)(uintptr_t)V_lds + v_rd_base(lane);
    const bf16_t* Kh = cur.K; const bf16_t* Vh = cur.V;
    unsigned long long selm = ~0ull;
    if (cur.sel) { const u32x2 w = *(const u32x2*)(cur.sel + 2 * (wid * QBLK + r32)); selm = ((unsigned long long)w[1] << 32) | w[0]; }
#define RESC(a) do { if (__any((a) < 1.f)) { if (hi == 0) al_l[r32] = (a); asm volatile("s_waitcnt lgkmcnt(0)" ::: "memory");              \
                     for (int d_ = 0; d_ < 4; ++d_) for (int r = 0; r < 16; ++r) o[d_][r] *= al_l[crow(r, hi)]; } } while (0)
#define KBASE(t) ((j_lo + (t)) * KVBLK)
#define MASKT(P0_, P1_, t) do { const int kb_ = KBASE(t); if (kb_ + KVBLK - 1 > qlo || kb_ <= qlo + QBLK - 1 - W) mask_tile(P0_, P1_, qm - kb_, (unsigned)W); \
        if (cur.sel) { if (!((selm >> (j_lo + (t))) & 1ull)) { const float NEG_ = -__builtin_inff(); for (int r = 0; r < 16; ++r) { P0_[r] = NEG_; P1_[r] = NEG_; } } } } while (0)
    constexpr int NQL = 8;
#define SEAM_K0() do { VMWN(NQL); SWRITE_HK(0); SBAR(); } while (0)
    f32x16 pA0, pA1, pB0, pB1; float mnA, mnB, alA, alB; bf16x8 pa0, pa1, pa2, pa3;
    SWRITE_HV(0); SBAR();
    if (NT_ > 1) { SLOAD_H(Kh, Vh, KBASE(1)); }
    SBAR(); qkt<0>(pA0, pA1, K_lds, r32, hi, S.qr);
    MASKT(pA0, pA1, 0); partialSM(pA0, pA1, m_reg, mnA, alA);
    if (NT_ > 1) { VMW(); SWRITE_H(1); }
    __syncthreads();
#define HALF_STEP(PX0, PX1, mnX, alX, PY0, PY1, alY, t, KB, VB, SB) do {                                                      \
        SBAR(); qkt<KB>(PX0, PX1, K_lds, r32, hi, S.qr);                                             \
        finishSM(PY0, PY1, alY, l_reg, pa0, pa1, pa2, pa3); SBAR();                                                           \
        if ((t) + 1 < NT_) { SLOAD_H(Kh, Vh, KBASE((t) + 1)); SBAR(); }                                               \
        pv_tile<VB>(o, vb0, pa0, pa1, pa2, pa3); MASKT(PX0, PX1, (t)); partialSM(PX0, PX1, m_reg, mnX, alX);                                        \
        __syncthreads();                                                                                                      \
        if ((t) + 1 < NT_) { VMW(); SWRITE_H(SB); }                                                                          \
        RESC(alX); __syncthreads(); } while (0)
    for (int t = 1; t + 1 < NT_; t += 2) {
        HALF_STEP(pB0, pB1, mnB, alB, pA0, pA1, alA, t, 1, 0, 0);
        HALF_STEP(pA0, pA1, mnA, alA, pB0, pB1, alB, t + 1, 0, 1, 1);
    }
    const bool even = (NT_ & 1) == 0;
    if (even) { SBAR(); qkt<1>(pB0, pB1, K_lds, r32, hi, S.qr); SBAR(); }
    const BlockRef nxt = make_ref(Ln, stepn, hf, PROJ, NSAF, NSA, SEL);
    const int kbn = swa_jlo(nxt.P0, nxt.W) * KVBLK;
    SLOAD_H(nxt.K, nxt.V, kbn); SBAR();
#pragma unroll
    for (int d0 = 0; d0 < 8; ++d0) S.qr[d0] = load8(nxt.Q + (size_t)(wid * QBLK + r32) * LDP + d0 * 16 + hi * 8);
    SBAR();
    finishSM(pA0, pA1, alA, l_reg, pa0, pa1, pa2, pa3); SBAR();
    pv_tile<0>(o, vb0, pa0, pa1, pa2, pa3);
    if (even) { MASKT(pB0, pB1, NT_ - 1); partialSM(pB0, pB1, m_reg, mnB, alB); __syncthreads(); RESC(alB);
        finishSM(pB0, pB1, alB, l_reg, pa0, pa1, pa2, pa3); SBAR(); pv_tile<1>(o, vb0, pa0, pa1, pa2, pa3); }
    SBAR(); SEAM_K0();
    { const float gatev = 1.f / (1.f + __expf(-bf2f(cur.gate[(size_t)(wid * QBLK + r32) * LDP]))); if (hi == 0) li_l[r32] = gatev / l_reg; } asm volatile("s_waitcnt lgkmcnt(0)" ::: "memory");
    float rli[16];
#pragma unroll
    for (int r = 0; r < 16; ++r) rli[r] = li_l[crow(r, hi)];
    float* Ow = cur.Of + (size_t)(wid * QBLK) * DM;
    if (cur.mode == 0) {
#pragma unroll
        for (int r = 0; r < 16; ++r) { const int orow = crow(r, hi);
#pragma unroll
            for (int d0 = 0; d0 < 4; ++d0) { float* p = Ow + (size_t)orow * DM + d0 * 32 + r32; *p = *p + o[d0][r] * rli[r]; } }
    } else {
        bf16_t* Obw = cur.Ob + (size_t)(wid * QBLK) * DM;
#pragma unroll
        for (int r = 0; r < 16; ++r) { const int orow = crow(r, hi);
#pragma unroll
            for (int d0 = 0; d0 < 4; ++d0) { const float v = o[d0][r] * rli[r] + Ow[(size_t)orow * DM + d0 * 32 + r32];
                const float vn = swz<1>(v);
                if ((r32 & 1) == 0) *(unsigned*)(Obw + (size_t)orow * DM + d0 * 32 + r32) = pk2(v, vn); } }
    }
    __syncthreads();
#undef RESC
#undef KBASE
#undef MASKT
#undef SEAM_K0
#undef HALF_STEP
}
#undef ROW
#undef VMW
#undef VMWN
#undef SLOAD_H
#undef SWRITE_HK
#undef SWRITE_HV
#undef SWRITE_H
DI void phase(int hf, const bf16_t* PROJ, float* NSAF, bf16_t* NSA, const unsigned* SEL, char* lds, int bid, int G, int wv) {
    const int total = 2 * 16 * 8;
    int L = bid; if (L >= total) return;
    int step = 0;
    BlockRef cur = make_ref(L, 0, hf, PROJ, NSAF, NSA, SEL);
    Seam S;
    prime(cur, lds, S, wv);
    for (;;) {
        int Ln = L, stepn = step + 1;
        if (stepn == 4) { stepn = 0; Ln = L + G; }
        const bool last = (stepn == 0 && Ln >= total);
        if (last) { Ln = L; stepn = step; }
        block(cur, Ln, stepn, hf, PROJ, NSAF, NSA, SEL, SEQ, lds, S, wv);
        if (last) break;
        L = Ln; step = stepn; cur = make_ref(L, step, hf, PROJ, NSAF, NSA, SEL);
    }
}
}

DI void conv_unit(int unit, const bf16_t* __restrict__ U, const float* __restrict__ cw, const float* __restrict__ cb, bf16_t* __restrict__ ACT) {
    const int cgp = unit % (DFF / 8), rb = unit / (DFF / 8);
    const int r0 = rb * 16, col = cgp * 8;
    float wa[3][8], wb[3][8], ba[8], bb[8];
#pragma unroll
    for (int k = 0; k < 3; ++k) { const f32x4 a0 = *(const f32x4*)(cw + k * DFF2 + col), a1 = *(const f32x4*)(cw + k * DFF2 + col + 4), b0 = *(const f32x4*)(cw + k * DFF2 + DFF + col), b1 = *(const f32x4*)(cw + k * DFF2 + DFF + col + 4);
#pragma unroll
        for (int j = 0; j < 4; ++j) { wa[k][j] = a0[j]; wa[k][4 + j] = a1[j]; wb[k][j] = b0[j]; wb[k][4 + j] = b1[j]; } }
    { const f32x4 a0 = *(const f32x4*)(cb + col), a1 = *(const f32x4*)(cb + col + 4), b0 = *(const f32x4*)(cb + DFF + col), b1 = *(const f32x4*)(cb + DFF + col + 4);
#pragma unroll
      for (int j = 0; j < 4; ++j) { ba[j] = a0[j]; ba[4 + j] = a1[j]; bb[j] = b0[j]; bb[4 + j] = b1[j]; } }
    u32x4 a2 = {0, 0, 0, 0}, a1 = {0, 0, 0, 0}, b2 = {0, 0, 0, 0}, b1 = {0, 0, 0, 0};
    if ((r0 & (SEQ - 1)) != 0) { const bf16_t* p = U + (size_t)(r0 - 2) * DFF2 + col; a2 = *(const u32x4*)p; b2 = *(const u32x4*)(p + DFF); a1 = *(const u32x4*)(p + DFF2); b1 = *(const u32x4*)(p + DFF2 + DFF); }
#pragma unroll
    for (int rr = 0; rr < 16; rr += 8) {
        u32x4 av[8], bv[8];
#pragma unroll
        for (int r = 0; r < 8; ++r) { const bf16_t* p = U + (size_t)(r0 + rr + r) * DFF2 + col; av[r] = *(const u32x4*)p; bv[r] = *(const u32x4*)(p + DFF); }
#pragma unroll
        for (int r = 0; r < 8; ++r) {
            const u32x4 a0 = av[r], b0 = bv[r];
            float res[8];
#pragma unroll
            for (int j = 0; j < 4; ++j) {
                const float ua0 = wa[0][2 * j] * bflo(a2[j]) + wa[1][2 * j] * bflo(a1[j]) + wa[2][2 * j] * bflo(a0[j]) + ba[2 * j];
                const float ua1 = wa[0][2 * j + 1] * bfhi(a2[j]) + wa[1][2 * j + 1] * bfhi(a1[j]) + wa[2][2 * j + 1] * bfhi(a0[j]) + ba[2 * j + 1];
                const float ub0 = wb[0][2 * j] * bflo(b2[j]) + wb[1][2 * j] * bflo(b1[j]) + wb[2][2 * j] * bflo(b0[j]) + bb[2 * j];
                const float ub1 = wb[0][2 * j + 1] * bfhi(b2[j]) + wb[1][2 * j + 1] * bfhi(b1[j]) + wb[2][2 * j + 1] * bfhi(b0[j]) + bb[2 * j + 1];
                res[2 * j] = siluf_(ua0) * ub0; res[2 * j + 1] = siluf_(ua1) * ub1;
            }
            u32x4 w = {pk2(res[0], res[1]), pk2(res[2], res[3]), pk2(res[4], res[5]), pk2(res[6], res[7])};
            *(u32x4*)(ACT + (size_t)(r0 + rr + r) * DFF + col) = w;
            a2 = a1; a1 = a0; b2 = b1; b1 = b0;
        }
    }
}

struct Args { const float* in[19]; float* out; unsigned char* ws; };
#define CAS __attribute__((address_space(4)))
DI const CAS char* karg_() { const CAS char* ka = (const CAS char*)__builtin_amdgcn_kernarg_segment_ptr(); asm volatile("" : "+s"(ka)); return ka; }
#define INP(i) (*(const float* const CAS*)(karg_() + 8 * (i)))
#define OUTP() (*(float* const CAS*)(karg_() + 8 * 19))
#define WSP() (*(unsigned char* const CAS*)(karg_() + 8 * 20))

__global__ void __launch_bounds__(NT, 2) fwd_kernel(Args a) {
    extern __shared__ __attribute__((aligned(16))) unsigned char lds_raw[];
    LAS unsigned char* lds = (LAS unsigned char*)lds_raw;
    cg::grid_group grid = cg::this_grid();
    const int G = gridDim.x, bid = blockIdx.x;
    const int wv0 = __builtin_amdgcn_readfirstlane((int)threadIdx.x >> 6);
    const int NGW = G * 8;
    volatile LAS unsigned* xb_st = (volatile LAS unsigned*)(lds + LDS_BYTES - 16);
    if (threadIdx.x < 4) xb_st[threadIdx.x] = 0u;
    __syncthreads();
    const unsigned xb_x = xb_xcc_id();
    if (threadIdx.x == 0) (void)xb_add((unsigned*)WSP() + XB_XCNT(xb_x), 1u);
#define GBAR() grid_bar((unsigned*)WSP(), xb_st, xb_x, G, wv0)
#ifndef PROBE_PHASE
#define PROBE_PHASE -1
#endif
    unsigned long long pt0 = 0;
#define PB(n) do { if (PROBE_PHASE == (n)) pt0 = __builtin_amdgcn_s_memrealtime(); } while (0)
#define PE(n) do { if (PROBE_PHASE == (n)) { const unsigned long long t1 = __builtin_amdgcn_s_memrealtime(); const unsigned long long dt = t1 - pt0; while (__builtin_amdgcn_s_memrealtime() - t1 < dt) __builtin_amdgcn_s_sleep(8); } } while (0)
#define PHASE_IDS() const int tid = tid_(wv0), lane = tid & 63, wave = __builtin_amdgcn_readfirstlane(tid >> 6), gw = bid * 8 + wave; (void)lane; (void)gw; \
    unsigned char* ws = WSP(); const float* x = INP(0); float* out = OUTP(); (void)x; (void)out; LAS float* scr = (LAS float*)(lds + wave * 17408); (void)scr; \
    bf16_t* WIN_T = (bf16_t*)(ws + WS_WIN); bf16_t* WRET_T = (bf16_t*)(ws + WS_WRET); bf16_t* WNSA_T = (bf16_t*)(ws + WS_WNSA); bf16_t* WOUT_T = (bf16_t*)(ws + WS_WOUT); \
    bf16_t* XN = (bf16_t*)(ws + WS_XN); bf16_t* ARET = XN; bf16_t* PROJ = (bf16_t*)(ws + WS_PROJ); bf16_t* NSA = (bf16_t*)(ws + WS_NSA); \
    bf16_t* KT = (bf16_t*)(ws + WS_KT); bf16_t* VT = (bf16_t*)(ws + WS_VT); bf16_t* STATE = (bf16_t*)(ws + WS_STATE); bf16_t* MX = (bf16_t*)(ws + WS_MX); \
    float* ROTC = (float*)(ws + WS_ROTC); float* ROTS = (float*)(ws + WS_ROTS); \
    bf16_t* W1K_T = (bf16_t*)(ws + WS_W1K); bf16_t* W1V_T = (bf16_t*)(ws + WS_W1V); bf16_t* W2K_T = (bf16_t*)(ws + WS_W2K); bf16_t* W2V_T = (bf16_t*)(ws + WS_W2V); \
    float* KCMP = (float*)(ws + WS_KP); float* VCMPT = (float*)(ws + WS_VP); unsigned* SEL = (unsigned*)(ws + WS_SEL); \
    (void)W1K_T; (void)W1V_T; (void)W2K_T; (void)W2V_T; (void)KCMP; (void)VCMPT; (void)SEL; \
    bf16_t* WUP_T = (bf16_t*)(ws + WS_WUP); bf16_t* WDOWN_T = (bf16_t*)(ws + WS_WDOWN); bf16_t* XN2 = (bf16_t*)(ws + WS_XN2); bf16_t* U = (bf16_t*)(ws + WS_U); bf16_t* ACT = (bf16_t*)(ws + WS_ACT); \
    (void)WIN_T; (void)WRET_T; (void)WNSA_T; (void)WOUT_T; (void)XN; (void)ARET; (void)PROJ; (void)NSA; (void)KT; (void)VT; (void)STATE; (void)MX; (void)ROTC; (void)ROTS; (void)WUP_T; (void)WDOWN_T; (void)XN2; (void)U; (void)ACT;

#if STAGE >= 2
    PB(0);
    { PHASE_IDS();
        constexpr int I_IN = 32 * 220, I_SQ = 32 * 32;
        constexpr int I_W1 = 64 * 4, I_W2 = 4 * 2;
        constexpr int NIT = I_IN + 3 * I_SQ + 2 * I_W1 + 2 * I_W2;
        for (int it = gw; it < NIT; it += NGW) {
            int r = it;
            if (r >= I_IN + 3 * I_SQ) { r -= I_IN + 3 * I_SQ;
                if (r < I_W1) { transpose_item(INP(6), 4096, 256, W1K_T, scr, r, 4, lane); continue; } r -= I_W1;
                if (r < I_W1) { transpose_item(INP(9), 4096, 256, W1V_T, scr, r, 4, lane); continue; } r -= I_W1;
                if (r < I_W2) { transpose_item(INP(7), 256, 128, W2K_T, scr, r, 2, lane); continue; } r -= I_W2;
                transpose_item(INP(10), 256, 128, W2V_T, scr, r, 2, lane); continue; }
            if (r < I_IN) { transpose_item(INP(2), DM, NCOL, WIN_T, scr, r, 220, lane); continue; } r -= I_IN;
            if (r < I_SQ) { transpose_item(INP(4), DM, DM, WRET_T, scr, r, 32, lane); continue; } r -= I_SQ;
            if (r < I_SQ) { transpose_item(INP(11), DM, DM, WNSA_T, scr, r, 32, lane); continue; } r -= I_SQ;
            transpose_item(INP(12), DM, DM, WOUT_T, scr, r, 32, lane);
        }
        for (int i = bid * NT + tid; i < SEQ * 64; i += G * NT) {
            const int pos = i >> 6, f = i & 63;
            const float freq = exp2f(-(float)f * (13.287712379549449f / 64.f));
            const float ang = (float)pos * freq;
            ROTC[i] = cosf(ang); ROTS[i] = sinf(ang);
        }
        for (int m = gw; m < MH; m += NGW) rms_row_bf16(x + (size_t)m * DM, INP(1), XN + (size_t)m * DM, lane);
    }
    PE(0);
    grid.sync();
    { constexpr int hf = 0;
        const size_t grow0 = (size_t)hf * MH;
        { PHASE_IDS();
            pg8::Gemm g{XN, WIN_T, MH, LDP, DM}; pg8::StaticOrder S; S.init(MH, LDP, G, bid);
            pg8::Epi<0> E{PROJ, LDP, nullptr, 0, nullptr, 0, nullptr, nullptr};
            pg8::gemm_phase(lds, g, S, E, wv0);
        }
        GBAR();
        PB(2);
        { PHASE_IDS(); for (int ci = bid; ci < 16 * 32; ci += G) {
              const int it0 = (ci >> 5) * 64 + (ci & 31) * 2;
              rot_item(it0, PROJ, ROTC, ROTS, KT, VT, lds, wv0); rot_item(it0 + 1, PROJ, ROTC, ROTS, KT, VT, lds, wv0);
              asm volatile("s_waitcnt vmcnt(0)" ::: "memory"); __syncthreads();
              retA_item(ci, KT, VT, STATE, wv0); } }
#if STAGE >= 3
        { PHASE_IDS(); for (int it = G - 1 - bid; it < 256; it += G) cmp_item(it, hf, PROJ, INP(5), INP(8), W1K_T, W1V_T, W2K_T, W2V_T, KCMP, VCMPT, lds, wv0); }
#endif
        PE(2); GBAR(); PB(3);
        { PHASE_IDS(); for (int i = bid * NT + tid; i < 131072; i += G * NT) retB_scan(STATE, i, wv0); }
#if STAGE >= 3
        { PHASE_IDS(); for (int it = bid; it < 512; it += G) cattn_item(it, hf, PROJ, KCMP, VCMPT, out + grow0 * DM, SEL, lds, wv0); }
#endif
        PE(3); GBAR(); PB(4);
#if STAGE >= 3
        { PHASE_IDS(); att::phase(hf, PROJ, out + grow0 * DM, NSA, SEL, (char*)lds_raw, bid, G, wv0); }
#endif
        { PHASE_IDS(); for (int it = bid; it < 16 * 32; it += G) retC_item(it, PROJ, VT, STATE, INP(3), ARET, lds, wv0); }
        PE(4); GBAR();
#if STAGE >= 3
        { PHASE_IDS();
            pg8::Gemm g{ARET, WRET_T, MH, DM, DM, NSA, WNSA_T}; pg8::StaticOrder S; S.init(MH, DM, G, bid);
            pg8::Epi<6> E{MX, DM, PROJ + C_MG, LDP, nullptr, 0, nullptr, nullptr};
            pg8::gemm_phase<pg8::Epi<6>, true>(lds, g, S, E, wv0);
        }
#else
        { PHASE_IDS();
            pg8::Gemm g{ARET, WRET_T, MH, DM, DM}; pg8::StaticOrder S; S.init(MH, DM, G, bid);
            pg8::Epi<1> E{out + grow0 * DM, DM, PROJ + C_MG, LDP, nullptr, 0, nullptr, nullptr};
            pg8::gemm_phase(lds, g, S, E, wv0);
        }
        GBAR();
        { PHASE_IDS(); for (size_t i = (size_t)bid * NT + tid; i < (size_t)MH * DM / 4; i += (size_t)G * NT) {
            const f32x4 v = *((const f32x4*)(out + grow0 * DM) + i); u32x2 o = {pk2(v.x, v.y), pk2(v.z, v.w)}; *((u32x2*)MX + i) = o; } }
#endif
        GBAR();
        { PHASE_IDS();
            pg8::Gemm g{MX, WOUT_T, MH, DM, DM}; pg8::StaticOrder S; S.init(MH, DM, G, bid);
            pg8::Epi<3> E{out + grow0 * DM, DM, x + grow0 * DM, DM, nullptr, 0, nullptr, nullptr};
            pg8::gemm_phase(lds, g, S, E, wv0);
        }
        if (hf == 0) { PHASE_IDS(); for (int m = gw; m < MH; m += NGW) rms_row_bf16(x + (size_t)(MH + m) * DM, INP(1), XN + (size_t)m * DM, lane); }
        GBAR();
    }
    { constexpr int hf = 1;
        const size_t grow0 = (size_t)hf * MH;
        { PHASE_IDS();
            pg8::Gemm g{XN, WIN_T, MH, LDP, DM}; pg8::StaticOrder S; S.init(MH, LDP, G, bid);
            pg8::Epi<0> E{PROJ, LDP, nullptr, 0, nullptr, 0, nullptr, nullptr};
            pg8::gemm_phase(lds, g, S, E, wv0);
        }
        GBAR();
        PB(2);
        { PHASE_IDS(); for (int ci = bid; ci < 16 * 32; ci += G) {
              const int it0 = (ci >> 5) * 64 + (ci & 31) * 2;
              rot_item(it0, PROJ, ROTC, ROTS, KT, VT, lds, wv0); rot_item(it0 + 1, PROJ, ROTC, ROTS, KT, VT, lds, wv0);
              asm volatile("s_waitcnt vmcnt(0)" ::: "memory"); __syncthreads();
              retA_item(ci, KT, VT, STATE, wv0); } }
#if STAGE >= 3
        { PHASE_IDS(); for (int it = G - 1 - bid; it < 256; it += G) cmp_item(it, hf, PROJ, INP(5), INP(8), W1K_T, W1V_T, W2K_T, W2V_T, KCMP, VCMPT, lds, wv0); }
#endif
        PE(2); GBAR(); PB(3);
        { PHASE_IDS(); for (int i = bid * NT + tid; i < 131072; i += G * NT) retB_scan(STATE, i, wv0); }
#if STAGE >= 3
        { PHASE_IDS(); for (int it = bid; it < 512; it += G) cattn_item(it, hf, PROJ, KCMP, VCMPT, out + grow0 * DM, SEL, lds, wv0); }
#endif
        PE(3); GBAR(); PB(4);
#if STAGE >= 3
        { PHASE_IDS(); att::phase(hf, PROJ, out + grow0 * DM, NSA, SEL, (char*)lds_raw, bid, G, wv0); }
#endif
        { PHASE_IDS(); for (int it = bid; it < 16 * 32; it += G) retC_item(it, PROJ, VT, STATE, INP(3), ARET, lds, wv0); }
        PE(4); GBAR();
#if STAGE >= 3
        { PHASE_IDS();
            pg8::Gemm g{ARET, WRET_T, MH, DM, DM, NSA, WNSA_T}; pg8::StaticOrder S; S.init(MH, DM, G, bid);
            pg8::Epi<6> E{MX, DM, PROJ + C_MG, LDP, nullptr, 0, nullptr, nullptr};
            pg8::gemm_phase<pg8::Epi<6>, true>(lds, g, S, E, wv0);
        }
#else
        { PHASE_IDS();
            pg8::Gemm g{ARET, WRET_T, MH, DM, DM}; pg8::StaticOrder S; S.init(MH, DM, G, bid);
            pg8::Epi<1> E{out + grow0 * DM, DM, PROJ + C_MG, LDP, nullptr, 0, nullptr, nullptr};
            pg8::gemm_phase(lds, g, S, E, wv0);
        }
        GBAR();
        { PHASE_IDS(); for (size_t i = (size_t)bid * NT + tid; i < (size_t)MH * DM / 4; i += (size_t)G * NT) {
            const f32x4 v = *((const f32x4*)(out + grow0 * DM) + i); u32x2 o = {pk2(v.x, v.y), pk2(v.z, v.w)}; *((u32x2*)MX + i) = o; } }
#endif
        GBAR();
        { PHASE_IDS();
            pg8::Gemm g{MX, WOUT_T, MH, DM, DM}; pg8::StaticOrder S; S.init(MH, DM, G, bid);
            pg8::Epi<3> E{out + grow0 * DM, DM, x + grow0 * DM, DM, nullptr, 0, nullptr, nullptr};
            pg8::gemm_phase(lds, g, S, E, wv0);
        }
        if (hf == 0) { PHASE_IDS(); for (int m = gw; m < MH; m += NGW) rms_row_bf16(x + (size_t)(MH + m) * DM, INP(1), XN + (size_t)m * DM, lane); }
        GBAR();
    }
#else
    { PHASE_IDS(); for (size_t i = (size_t)bid * NT + tid; i < (size_t)MTOK * DM / 4; i += (size_t)G * NT) ((f32x4*)out)[i] = ((const f32x4*)x)[i]; }
    GBAR();
#endif
    PB(8);
    { PHASE_IDS();
        constexpr int I_UP = 32 * 176, I_DN = 88 * 32;
        for (int it = gw; it < I_UP + I_DN; it += NGW) {
            if (it < I_UP) transpose_item<true>(INP(14), DM, DFF2, WUP_T, scr, it, 176, lane);
            else transpose_item(INP(17), DFF, DM, WDOWN_T, scr, it - I_UP, 32, lane);
        }
        for (int m = gw; m < MTOK; m += NGW) rms_row_bf16(out + (size_t)m * DM, INP(13), XN2 + (size_t)m * DM, lane);
    }
    PE(8); GBAR();
    { PHASE_IDS();
        pg8::Gemm g{XN2, WUP_T, MTOK, DFF2, DM}; pg8::StaticOrder S; S.init(MTOK, DFF2, G, bid);
        pg8::Epi<5> E{ACT, DFF, INP(15), 0, INP(16), 0, (float*)(ws + WS_UB), (float*)(ws + WS_PB)};
        pg8::gemm_phase(lds, g, S, E, wv0);
    }
    GBAR();
    { PHASE_IDS();
        const float* cw = INP(15); const float* UB = (const float*)(ws + WS_UB); const float* PB = (const float*)(ws + WS_PB);
        for (int idx = bid * NT + tid; idx < 256 * 2 * (DFF / 4); idx += G * NT) {
            const int sidx = idx / (2 * (DFF / 4)), rem = idx % (2 * (DFF / 4)), q = rem / (DFF / 4), c4 = (rem % (DFF / 4)) * 4;
            const int row = 64 * sidx + q;
            const float* pp = PB + (size_t)(2 * sidx + q) * DFF2 + c4;
            f32x4 pa = *(const f32x4*)pp, pb = *(const f32x4*)(pp + DFF);
            if ((row & (SEQ - 1)) >= 2) {
                const float* u62 = UB + (size_t)(2 * (sidx - 1)) * DFF2 + c4; const float* u63 = u62 + DFF2;
                const f32x4 wa0 = *(const f32x4*)(cw + c4), wa1 = *(const f32x4*)(cw + DFF2 + c4), wb0 = *(const f32x4*)(cw + DFF + c4), wb1 = *(const f32x4*)(cw + DFF2 + DFF + c4);
                if (q == 0) { pa = pa + wa1 * *(const f32x4*)u63 + wa0 * *(const f32x4*)u62; pb = pb + wb1 * *(const f32x4*)(u63 + DFF) + wb0 * *(const f32x4*)(u62 + DFF); }
                else { pa = pa + wa0 * *(const f32x4*)u63; pb = pb + wb0 * *(const f32x4*)(u63 + DFF); }
            }
            u32x2 w = {pk2(siluf_(pa[0]) * pb[0], siluf_(pa[1]) * pb[1]), pk2(siluf_(pa[2]) * pb[2], siluf_(pa[3]) * pb[3])};
            *(u32x2*)(ACT + (size_t)row * DFF + c4) = w;
        }
    }
    GBAR();
    { PHASE_IDS();
        pg8::Gemm g{ACT, WDOWN_T, MTOK, DM, DFF}; pg8::StaticOrder S; S.init(MTOK, DM, G, bid);
        pg8::Epi<4> E{out, DM, nullptr, 0, nullptr, 0, nullptr, nullptr};
        pg8::gemm_phase(lds, g, S, E, wv0);
    }
    GBAR();
    PB(12);
    { PHASE_IDS(); for (int m = gw; m < MTOK; m += NGW) rms_row_f32(out + (size_t)m * DM, INP(18), lane); }
    PE(12);
}

extern "C" void kernel_launch(void* const* d_in, const int* in_sizes, int n_in, void* d_out, int out_size, void* d_ws, size_t ws_size, hipStream_t stream) {
    static int grid = 0;
    if (grid == 0) {
        if (n_in != 19 || out_size != MTOK * DM || ws_size < WS_END) { fprintf(stderr, "kernel_launch: unexpected shapes (n_in %d out %d ws %zu)\n", n_in, out_size, ws_size); grid = -1; return; }
        int dev = 0, cus = 0, per_cu = 0;
        (void)hipGetDevice(&dev); (void)hipDeviceGetAttribute(&cus, hipDeviceAttributeMultiprocessorCount, dev);
        if (hipFuncSetAttribute((const void*)fwd_kernel, hipFuncAttributeMaxDynamicSharedMemorySize, LDS_BYTES) != hipSuccess) { fprintf(stderr, "hipFuncSetAttribute failed\n"); grid = -1; return; }
        if (hipOccupancyMaxActiveBlocksPerMultiprocessor(&per_cu, (const void*)fwd_kernel, NT, LDS_BYTES) != hipSuccess || per_cu < 1) { fprintf(stderr, "occupancy query: %d\n", per_cu); per_cu = 1; }
        (void)hipGetLastError();
        grid = cus > 0 ? cus : 256;
    }
    if (grid < 0) return;
    Args a{};
    for (int i = 0; i < 19; ++i) a.in[i] = (const float*)d_in[i];
    a.out = (float*)d_out; a.ws = (unsigned char*)d_ws;
    (void)hipMemsetAsync(d_ws, 0, XCD_BAR_WORDS * 4, stream);
    void* args[] = {&a};
    hipError_t e = hipLaunchCooperativeKernel((const void*)fwd_kernel, dim3(grid), dim3(NT), args, LDS_BYTES, stream);
    if (e != hipSuccess) fprintf(stderr, "cooperative launch failed: %s (grid %d)\n", hipGetErrorString(e), grid);
}
```
